# Optimizing an MI355X kernel written in HIP

```python
import math
import jax, jax.numpy as jnp
from jax import lax
import numpy as np

D_MODEL = 1024
BATCH = 2
SEQ = 8192
DEPTH = 4
DEC_BATCH = 8
DEC_SEQ = 32
PAST_LEN = 1024

CHUNK = 64
N_MIXERS = 2
N_A_LAYERS = (DEPTH + 1) // 2
N_B_LAYERS = DEPTH // 2
D_MIX = D_MODEL
S5_GROUP = 16
S5_GROUPS = D_MIX // S5_GROUP
S5_STATE = 64
POOL_WINDOWS = (2, 4, 8, 16)
POOL_GROUPS = len(POOL_WINDOWS)
POOL_GW = D_MIX // POOL_GROUPS
POOL_HIST = max(POOL_WINDOWS) - 1
D_FF = 2816
N_MEM = 256
N_XHEADS = 4
XHEAD_DIM = D_MODEL // N_XHEADS
N_SUB = 4
RMS_EPS = 1e-6

kernel_name = "s5_pool_macaron_stream_step"


def rmsnorm(x, g):
    xf = x.astype(jnp.float32)
    y = xf * lax.rsqrt(jnp.mean(xf * xf, axis=-1, keepdims=True) + RMS_EPS)
    return (y * g.astype(jnp.float32)).astype(x.dtype)


def swiglu(h, w_gate, w_up, w_down):
    return (jax.nn.silu(h @ w_gate) * (h @ w_up)) @ w_down


def s5_discretise(a_re, a_im, b_re, b_im, log_dt):
    f32 = jnp.float32
    lam = lax.complex(a_re.astype(f32), a_im.astype(f32))
    dt = jnp.exp(log_dt.astype(f32))[:, None]
    lam_bar = jnp.exp(lam * dt)
    b = lax.complex(b_re.astype(f32), b_im.astype(f32))
    b_bar = ((lam_bar - 1.0) / lam)[:, :, None] * b
    return lam_bar, b_bar


def _linear_combine(left, right):
    a_l, b_l = left
    a_r, b_r = right
    return a_r * a_l, a_r * b_l + b_r


def s5_block(h0, u_blk, lam_bar, b_bar, c):
    bu = jnp.einsum('gpc,btgc->btgp', b_bar, u_blk.astype(jnp.complex64))
    a = jnp.broadcast_to(lam_bar, bu.shape)
    a_cum, h_loc = lax.associative_scan(_linear_combine, (a, bu), axis=1)
    h = a_cum * h0[:, None] + h_loc
    y = jnp.einsum('gcp,btgp->btgc', c, h).real
    return h[:, -1], y


def s5_mixer(u, h0, a_re, a_im, b_re, b_im, c_re, c_im, d, log_dt, w_glu):
    f32 = jnp.float32
    bsz, t, _ = u.shape
    lam_bar, b_bar = s5_discretise(a_re, a_im, b_re, b_im, log_dt)
    c = lax.complex(c_re.astype(f32), c_im.astype(f32))
    ug = u.astype(f32).reshape(bsz, t, S5_GROUPS, S5_GROUP)
    if t > CHUNK:
        nc = t // CHUNK
        blocks = ug.reshape(bsz, nc, CHUNK, S5_GROUPS, S5_GROUP).transpose(1, 0, 2, 3, 4)

        def step(h, ub):
            return s5_block(h, ub, lam_bar, b_bar, c)

        h_last, ys = lax.scan(step, h0, blocks)
        y = ys.transpose(1, 0, 2, 3, 4).reshape(bsz, t, D_MIX)
    else:
        h_last, y = s5_block(h0, ug, lam_bar, b_bar, c)
        y = y.reshape(bsz, t, D_MIX)
    y = y + d.astype(f32) * u.astype(f32)
    z = jax.nn.gelu(y).astype(u.dtype)
    gate = z @ w_glu
    out = gate[..., :D_MODEL] * jax.nn.sigmoid(gate[..., D_MODEL:])
    return out, h_last


def pool_mixer(u, hist, pos0, w_grp, b_grp, scale):
    f32 = jnp.float32
    bsz, t, _ = u.shape
    ext = jnp.concatenate([hist.astype(u.dtype), u], axis=1)
    cs = jnp.cumsum(ext.astype(f32), axis=1)
    cs = jnp.concatenate([jnp.zeros((bsz, 1, D_MIX), f32), cs], axis=1)
    pos = pos0 + jnp.arange(t, dtype=jnp.int32)
    end = cs[:, POOL_HIST + 1:POOL_HIST + 1 + t]
    parts = []
    for g, w in enumerate(POOL_WINDOWS):
        sl = slice(g * POOL_GW, (g + 1) * POOL_GW)
        start = cs[:, POOL_HIST + 1 - w:POOL_HIST + 1 - w + t, sl]
        cnt = jnp.minimum(pos + 1, w).astype(f32)[None, :, None]
        parts.append((end[..., sl] - start) / cnt)
    pooled = jnp.concatenate(parts, axis=-1) - u.astype(f32)
    pooled = pooled.reshape(bsz, t, POOL_GROUPS, POOL_GW).astype(u.dtype)
    mixed = jnp.einsum('btgi,gio->btgo', pooled, w_grp) + b_grp
    out = mixed.reshape(bsz, t, D_MIX) * scale
    return out, ext[:, -POOL_HIST:]


def cross_attend(h, k, v, w_q, w_o):
    bsz, t, _ = h.shape
    q = (h @ w_q).reshape(bsz, t, N_XHEADS, XHEAD_DIM)
    s = jnp.einsum('bthd,bmhd->bhtm', q, k).astype(jnp.float32) * (XHEAD_DIM ** -0.5)
    p = jax.nn.softmax(s, axis=-1).astype(v.dtype)
    o = jnp.einsum('bhtm,bmhd->bthd', p, v).reshape(bsz, t, D_MODEL)
    return o @ w_o


def trunk(x, pos0, mem_k, mem_v, ssm_h0, pool_hist, p):
    new_h, new_buf = [], []
    for i in range(DEPTH):
        j = i // N_MIXERS
        h = rmsnorm(x, p['norm_pre'][i, 0])
        f = swiglu(h, p['ffn_w_gate'][i, 0], p['ffn_w_up'][i, 0], p['ffn_w_down'][i, 0])
        x = x + 0.5 * rmsnorm(f, p['norm_post'][i, 0])
        h = rmsnorm(x, p['norm_pre'][i, 1])
        if i % N_MIXERS == 0:
            mix, hs = s5_mixer(h @ p['s5_w_in'][j], ssm_h0[j], p['s5_a_re'][j], p['s5_a_im'][j],
                               p['s5_b_re'][j], p['s5_b_im'][j], p['s5_c_re'][j], p['s5_c_im'][j],
                               p['s5_d'][j], p['s5_log_dt'][j], p['s5_w_glu'][j])
            new_h.append(hs)
        else:
            mix, buf = pool_mixer(h @ p['pool_w_in'][j], pool_hist[j], pos0,
                                  p['pool_w_grp'][j], p['pool_b_grp'][j], p['pool_scale'][j])
            new_buf.append(buf)
        x = x + rmsnorm(mix, p['norm_post'][i, 1])
        h = rmsnorm(x, p['norm_pre'][i, 2])
        a = cross_attend(h, mem_k[i], mem_v[i], p['xa_w_q'][i], p['xa_w_o'][i])
        x = x + rmsnorm(a, p['norm_post'][i, 2])
        h = rmsnorm(x, p['norm_pre'][i, 3])
        f = swiglu(h, p['ffn_w_gate'][i, 1], p['ffn_w_up'][i, 1], p['ffn_w_down'][i, 1])
        x = x + 0.5 * rmsnorm(f, p['norm_post'][i, 3])
    return x, jnp.stack(new_h), jnp.stack(new_buf)


def setup_inputs(seed: int = 0) -> dict:
    key = jax.random.key(seed)
    ks = iter(jax.random.split(key, 40))
    f32 = jnp.float32

    def nrm(shape, scale=1.0):
        return jax.random.normal(next(ks), shape, f32) * scale

    n_idx = jnp.arange(S5_STATE, dtype=f32)
    inputs = {}
    inputs['x_prompt'] = nrm((BATCH, SEQ, D_MODEL))
    inputs['x_sample'] = nrm((DEC_BATCH, DEC_SEQ, D_MODEL))
    inputs['cache_mem_k'] = nrm((DEPTH, DEC_BATCH, N_MEM, N_XHEADS, XHEAD_DIM))
    inputs['cache_mem_v'] = nrm((DEPTH, DEC_BATCH, N_MEM, N_XHEADS, XHEAD_DIM))
    inputs['state_ssm_re'] = nrm((N_A_LAYERS, DEC_BATCH, S5_GROUPS, S5_STATE), 0.5)
    inputs['state_ssm_im'] = nrm((N_A_LAYERS, DEC_BATCH, S5_GROUPS, S5_STATE), 0.5)
    inputs['state_pool'] = nrm((N_A_LAYERS * 0 + N_B_LAYERS, DEC_BATCH, POOL_HIST, D_MIX))
    inputs['mem_prompt'] = nrm((BATCH, N_MEM, D_MODEL))
    inputs['norm_pre'] = 1.0 + nrm((DEPTH, N_SUB, D_MODEL), 0.05)
    inputs['norm_post'] = 1.0 + nrm((DEPTH, N_SUB, D_MODEL), 0.05)
    inputs['norm_mem'] = 1.0 + nrm((DEPTH, D_MODEL), 0.05)
    inputs['ffn_w_gate'] = nrm((DEPTH, 2, D_MODEL, D_FF), D_MODEL ** -0.5)
    inputs['ffn_w_up'] = nrm((DEPTH, 2, D_MODEL, D_FF), D_MODEL ** -0.5)
    inputs['ffn_w_down'] = nrm((DEPTH, 2, D_FF, D_MODEL), D_FF ** -0.5)
    inputs['xa_w_q'] = nrm((DEPTH, D_MODEL, D_MODEL), D_MODEL ** -0.5)
    inputs['xa_w_k'] = nrm((DEPTH, D_MODEL, D_MODEL), D_MODEL ** -0.5)
    inputs['xa_w_v'] = nrm((DEPTH, D_MODEL, D_MODEL), D_MODEL ** -0.5)
    inputs['xa_w_o'] = nrm((DEPTH, D_MODEL, D_MODEL), D_MODEL ** -0.5)
    inputs['s5_w_in'] = nrm((N_A_LAYERS, D_MODEL, D_MIX), D_MODEL ** -0.5)
    inputs['s5_a_re'] = -0.5 + nrm((N_A_LAYERS, S5_GROUPS, S5_STATE), 0.01)
    inputs['s5_a_im'] = jnp.broadcast_to(math.pi * n_idx, (N_A_LAYERS, S5_GROUPS, S5_STATE)) + nrm((N_A_LAYERS, S5_GROUPS, S5_STATE), 0.01)
    inputs['s5_b_re'] = nrm((N_A_LAYERS, S5_GROUPS, S5_STATE, S5_GROUP), (2 * S5_GROUP) ** -0.5)
    inputs['s5_b_im'] = nrm((N_A_LAYERS, S5_GROUPS, S5_STATE, S5_GROUP), (2 * S5_GROUP) ** -0.5)
    inputs['s5_c_re'] = nrm((N_A_LAYERS, S5_GROUPS, S5_GROUP, S5_STATE), (2 * S5_STATE) ** -0.5)
    inputs['s5_c_im'] = nrm((N_A_LAYERS, S5_GROUPS, S5_GROUP, S5_STATE), (2 * S5_STATE) ** -0.5)
    inputs['s5_d'] = nrm((N_A_LAYERS, D_MIX))
    inputs['s5_log_dt'] = jax.random.uniform(next(ks), (N_A_LAYERS, S5_GROUPS), f32, math.log(1e-3), math.log(1e-1))
    inputs['s5_w_glu'] = nrm((N_A_LAYERS, D_MIX, 2 * D_MODEL), D_MIX ** -0.5)
    inputs['pool_w_in'] = nrm((N_B_LAYERS, D_MODEL, D_MIX), D_MODEL ** -0.5)
    inputs['pool_w_grp'] = nrm((N_B_LAYERS, POOL_GROUPS, POOL_GW, POOL_GW), POOL_GW ** -0.5)
    inputs['pool_b_grp'] = nrm((N_B_LAYERS, POOL_GROUPS, POOL_GW), 0.02)
    inputs['pool_scale'] = 1.0 + nrm((N_B_LAYERS, D_MIX), 0.1)
    return inputs


def reference(x_prompt, x_sample, cache_mem_k, cache_mem_v, state_ssm_re, state_ssm_im, state_pool, mem_prompt,
              norm_pre, norm_post, norm_mem, ffn_w_gate, ffn_w_up, ffn_w_down,
              xa_w_q, xa_w_k, xa_w_v, xa_w_o,
              s5_w_in, s5_a_re, s5_a_im, s5_b_re, s5_b_im, s5_c_re, s5_c_im, s5_d, s5_log_dt, s5_w_glu,
              pool_w_in, pool_w_grp, pool_b_grp, pool_scale):
    f32 = jnp.float32
    p = dict(norm_pre=norm_pre, norm_post=norm_post, ffn_w_gate=ffn_w_gate, ffn_w_up=ffn_w_up,
             ffn_w_down=ffn_w_down, xa_w_q=xa_w_q, xa_w_o=xa_w_o, s5_w_in=s5_w_in, s5_a_re=s5_a_re,
             s5_a_im=s5_a_im, s5_b_re=s5_b_re, s5_b_im=s5_b_im, s5_c_re=s5_c_re, s5_c_im=s5_c_im,
             s5_d=s5_d, s5_log_dt=s5_log_dt, s5_w_glu=s5_w_glu, pool_w_in=pool_w_in,
             pool_w_grp=pool_w_grp, pool_b_grp=pool_b_grp, pool_scale=pool_scale)
    bsz = x_prompt.shape[0]

    m = rmsnorm(mem_prompt[None], norm_mem[:, None, None, :])
    mem_k_prompt = jnp.einsum('lbmd,lde->lbme', m, xa_w_k).reshape(DEPTH, bsz, N_MEM, N_XHEADS, XHEAD_DIM)
    mem_v_prompt = jnp.einsum('lbmd,lde->lbme', m, xa_w_v).reshape(DEPTH, bsz, N_MEM, N_XHEADS, XHEAD_DIM)
    h0_prompt = jnp.zeros((N_A_LAYERS, bsz, S5_GROUPS, S5_STATE), jnp.complex64)
    hist_prompt = jnp.zeros((N_B_LAYERS, bsz, POOL_HIST, D_MIX), x_prompt.dtype)
    y_prompt, h_p, buf_p = trunk(x_prompt, 0, mem_k_prompt, mem_v_prompt, h0_prompt, hist_prompt, p)

    h0_sample = lax.complex(state_ssm_re.astype(f32), state_ssm_im.astype(f32))
    y_sample, h_s, buf_s = trunk(x_sample, PAST_LEN, cache_mem_k, cache_mem_v, h0_sample, state_pool, p)

    sdt = state_ssm_re.dtype
    return (y_prompt, y_sample, mem_k_prompt, mem_v_prompt,
            jnp.real(h_p).astype(sdt), jnp.imag(h_p).astype(sdt), buf_p,
            jnp.real(h_s).astype(sdt), jnp.imag(h_s).astype(sdt), buf_s)
```

```cpp
#include <hip/hip_runtime.h>
#include <hip/hip_cooperative_groups.h>
#include <cstdio>
#include <cstring>
namespace cg = cooperative_groups;

#define LAS __attribute__((address_space(3)))
typedef unsigned short bf16_t;
typedef short bf16x8 __attribute__((ext_vector_type(8)));
typedef float f32x4 __attribute__((ext_vector_type(4)));
typedef unsigned u32x4 __attribute__((ext_vector_type(4)));
typedef unsigned u32x2 __attribute__((ext_vector_type(2)));

constexpr int D = 1024, DFF = 2816, TP = 16384, TT = 16640;
constexpr int CR = 1040, UK = 384;
constexpr long USTRIDE = (long)CR * UK;
constexpr float EPS = 1e-6f;
constexpr long M1 = 1024 * 1024;

constexpr size_t AL(size_t x) { return (x + 255) & ~(size_t)255; }
constexpr size_t O_WGU = 0;
constexpr size_t O_WDN = O_WGU + AL((size_t)8 * 5632 * 1024 * 2);
constexpr size_t O_WQT = O_WDN + AL((size_t)8 * 1024 * 2816 * 2);
constexpr size_t O_WOT = O_WQT + AL((size_t)4 * M1 * 2);
constexpr size_t O_WSI = O_WOT + AL((size_t)4 * M1 * 2);
constexpr size_t O_WPI = O_WSI + AL((size_t)2 * M1 * 2);
constexpr size_t O_WGL = O_WPI + AL((size_t)2 * M1 * 2);
constexpr size_t O_WGR = O_WGL + AL((size_t)2 * 2048 * 1024 * 2);
constexpr size_t O_TV  = O_WGR + AL((size_t)2 * 4 * 65536 * 2);
constexpr size_t O_W5  = O_TV + AL((size_t)2 * 64 * 256 * UK * 2);
constexpr size_t O_QK  = O_W5 + AL((size_t)2 * 64 * 128 * 256 * 2 + 128 * 256 * 2);
constexpr size_t O_VW  = O_QK + AL((size_t)8 * M1 * 2);
constexpr size_t O_LAM = O_VW + AL((size_t)8 * M1 * 2);
constexpr size_t O_H   = O_LAM + AL((size_t)2 * 64 * 64 * 4 * 4);
constexpr size_t O_Z   = O_H + AL((size_t)TT * D * 2);
constexpr size_t O_F   = O_Z + AL((size_t)TT * D * 2);
constexpr size_t O_ACT = O_F + AL((size_t)TT * D * 4);
constexpr size_t WS_END = O_ACT + AL((size_t)TT * DFF * 2);
constexpr size_t O_U   = O_ACT;
constexpr size_t O_S   = O_U + AL((size_t)64 * USTRIDE * 2 + 256 * UK * 2);
static_assert(O_S + (size_t)64 * CR * 128 * 4 <= WS_END, "U/S alias overflow");
constexpr size_t O_WKT = O_ACT;
constexpr size_t O_WQP = O_WKT + (size_t)8 * M1 * 2;
constexpr size_t O_AMEM = O_WQP + (size_t)4 * M1 * 2;
constexpr size_t O_KBF = O_AMEM + (size_t)4 * 512 * 1024 * 2;
static_assert(O_KBF + (size_t)8 * 512 * 1024 * 2 <= WS_END, "prep alias overflow");

constexpr long OO_MEMK = (long)TT * D;
constexpr long OO_SRP = OO_MEMK + 2 * 2097152L;
constexpr long OO_SIP = OO_SRP + 16384;
constexpr long OO_PP = OO_SIP + 16384;
constexpr long OO_SRS = OO_PP + 61440;
constexpr long OO_SIS = OO_SRS + 65536;
constexpr long OO_PS = OO_SIS + 65536;
constexpr long OUT_TOTAL = OO_PS + 245760;

struct TJob { const float* src; bf16_t* dst; long sbs, dbs; int lds, ldd, tr, tc, mode, nb, tile0, pad; };
constexpr int NJOBS = 14;
struct Params {
    const float* in[32];
    float* out;
    unsigned char* ws;
    TJob jobs[NJOBS];
    int ntiles, pad;
};

__device__ __forceinline__ unsigned char* opq_ptr(unsigned char* x) {
    unsigned lo = (unsigned)(unsigned long long)x, hi = (unsigned)((unsigned long long)x >> 32);
    asm volatile("" : "+v"(lo), "+v"(hi));
    lo = __builtin_amdgcn_readfirstlane(lo); hi = __builtin_amdgcn_readfirstlane(hi);
    return (unsigned char*)(((unsigned long long)hi << 32) | lo); }
__device__ __forceinline__ int opaque_tid() { int t = threadIdx.x; asm volatile("" : "+v"(t)); return t; }
__device__ __forceinline__ unsigned cvt_pk_bf16(float lo, float hi) { unsigned r; asm volatile("v_cvt_pk_bf16_f32 %0, %1, %2" : "=v"(r) : "v"(lo), "v"(hi)); return r; }
__device__ __forceinline__ float bf2f(unsigned short b) { return __uint_as_float(((unsigned)b) << 16); }
__device__ __forceinline__ float shx(float v, int mask, int lane) { return __int_as_float(__builtin_amdgcn_ds_bpermute((lane ^ mask) << 2, __float_as_int(v))); }
__device__ __forceinline__ float wave_sum(float v, int lane) {
#pragma unroll
    for (int o = 1; o < 64; o <<= 1) v += shx(v, o, lane);
    return v;
}
__device__ __forceinline__ float wave_max(float v, int lane) {
#pragma unroll
    for (int o = 1; o < 64; o <<= 1) v = fmaxf(v, shx(v, o, lane));
    return v;
}
__device__ __forceinline__ float fsigmoid(float x) { return __builtin_amdgcn_rcpf(1.0f + __expf(-x)); }
__device__ __forceinline__ float gelu_tanh(float y) {
    const float t = 0.7978845608028654f * (y + 0.044715f * y * y * y);
    return y * fsigmoid(2.0f * t);
}

constexpr int BM = 256, BK = 64, HALF = 128, HTB = HALF * BK * 2, STAGE_BYTES = 8 * HTB;
constexpr int LDS_X = STAGE_BYTES;
constexpr int LDS_BYTES = STAGE_BYTES + 8192;
__device__ __forceinline__ int lds_byte(int r, int c) { const int st = (r >> 4) * 2 + (c >> 5), rr = r & 15, cc = c & 31, ob = rr * 64 + cc * 2; return st * 1024 + (ob ^ (((ob >> 9) & 1) << 5)); }
__device__ __forceinline__ void stage_rc(int b, int& R, int& C) { const int st = b / 1024, sb = b % 1024, swz = sb ^ (((sb >> 9) & 1) << 5); R = (st >> 1) * 16 + swz / 64; C = (st & 1) * 32 + (swz % 64) / 2; }
__device__ __forceinline__ int perm32(int rho) { const int n = rho >> 4, i = rho & 15; return 8 * (i >> 2) + 4 * n + (i & 3); }

struct Unit { const char* a; const char* b; long c; int i0, i1, i2, i3; };
struct GD {
    const bf16_t* A; const bf16_t* B; int lda, ldb, nt, n, d0, d1, d2; int sa[4], sb[4], sc[4];
    __device__ __forceinline__ bool unit(long L, Unit& u) const {
        if (L >= n) return false;
        int l = (int)L; const int i0 = l % d0; l /= d0; const int i1 = l % d1; l /= d1; const int i2 = l % d2; const int i3 = l / d2;
        u.i0 = i0; u.i1 = i1; u.i2 = i2; u.i3 = i3;
        u.a = (const char*)(A + (long)(i0 * sa[0] + i1 * sa[1] + i2 * sa[2] + i3 * sa[3]));
        u.b = (const char*)(B + (long)(i0 * sb[0] + i1 * sb[1] + i2 * sb[2] + i3 * sb[3]));
        u.c = (long)(i0 * sc[0] + i1 * sc[1] + i2 * sc[2] + i3 * sc[3]);
        return true;
    }
};
__device__ __forceinline__ GD gd_zero() { GD g; g.A = nullptr; g.B = nullptr; g.lda = g.ldb = 0; g.nt = 0; g.n = 0; g.d0 = g.d1 = g.d2 = 1;
    for (int i = 0; i < 4; ++i) { g.sa[i] = 0; g.sb[i] = 0; g.sc[i] = 0; } return g; }
__device__ __forceinline__ GD gd_plain(const bf16_t* A, int lda, const bf16_t* B, int ldb, int K, int nM, int nN, int ldc, int ctile) {
    GD g = gd_zero(); g.A = A; g.B = B; g.lda = lda; g.ldb = ldb; g.nt = K / BK; g.n = nM * nN; g.d0 = nM; g.d1 = nN; g.d2 = 1;
    g.sa[0] = 256 * lda; g.sb[1] = 256 * ldb; g.sc[0] = 256 * ldc; g.sc[1] = ctile; return g; }

typedef f32x4 Acc[2][2][4][2];

struct EpiF32 {
    static constexpr bool PERM = false;
    float* C; int ldc; const float* bias; const float* scale;
    __device__ __forceinline__ void operator()(const Acc& acc, const Unit& u, int wr, int wc, int fr, int fq) const {
        const int cb = (int)(u.c % ldc);
        const int row0 = wr * 64 + fr, col0 = wc * 32 + 4 * fq;
        f32x4 bv[2][2], sv[2][2];
#pragma unroll
        for (int bj = 0; bj < 2; ++bj)
#pragma unroll
            for (int n = 0; n < 2; ++n) {
                bv[bj][n] = bias ? *(const f32x4*)(bias + cb + col0 + bj * HALF + n * 16) : (f32x4){0.f, 0.f, 0.f, 0.f};
                sv[bj][n] = scale ? *(const f32x4*)(scale + cb + col0 + bj * HALF + n * 16) : (f32x4){1.f, 1.f, 1.f, 1.f}; }
#pragma unroll
        for (int ai = 0; ai < 2; ++ai)
#pragma unroll
            for (int m = 0; m < 4; ++m) { float* rowp = C + u.c + (long)(row0 + ai * HALF + m * 16) * ldc + col0;
#pragma unroll
                for (int bj = 0; bj < 2; ++bj)
#pragma unroll
                    for (int n = 0; n < 2; ++n) *(f32x4*)(rowp + bj * HALF + n * 16) = (acc[ai][bj][m][n] + bv[bj][n]) * sv[bj][n]; }
    }
};
struct EpiF32Bf16 {
    static constexpr bool PERM = false;
    float* C; bf16_t* O; int ldc;
    __device__ __forceinline__ void operator()(const Acc& acc, const Unit& u, int wr, int wc, int fr, int fq) const {
        const int row0 = wr * 64 + fr, col0 = wc * 32 + 4 * fq;
#pragma unroll
        for (int ai = 0; ai < 2; ++ai)
#pragma unroll
            for (int m = 0; m < 4; ++m) { const long off = u.c + (long)(row0 + ai * HALF + m * 16) * ldc + col0;
#pragma unroll
                for (int bj = 0; bj < 2; ++bj)
#pragma unroll
                    for (int n = 0; n < 2; ++n) { const f32x4 v = acc[ai][bj][m][n]; *(f32x4*)(C + off + bj * HALF + n * 16) = v;
                        u32x2 w; w.x = cvt_pk_bf16(v[0], v[1]); w.y = cvt_pk_bf16(v[2], v[3]); *(u32x2*)(O + off + bj * HALF + n * 16) = w; } }
    }
};
struct EpiBf16 {
    static constexpr bool PERM = true;
    bf16_t* O; int ldc; float s;
    __device__ __forceinline__ void operator()(const Acc& acc, const Unit& u, int wr, int wc, int fr, int fq) const {
        const int row0 = wr * 64 + fr, col0 = wc * 32 + 8 * fq;
#pragma unroll
        for (int ai = 0; ai < 2; ++ai)
#pragma unroll
            for (int m = 0; m < 4; ++m) { bf16_t* rowp = O + u.c + (long)(row0 + ai * HALF + m * 16) * ldc + col0;
#pragma unroll
                for (int bj = 0; bj < 2; ++bj) { const f32x4 v0 = acc[ai][bj][m][0] * s, v1 = acc[ai][bj][m][1] * s;
                    u32x4 w; w.x = cvt_pk_bf16(v0[0], v0[1]); w.y = cvt_pk_bf16(v0[2], v0[3]); w.z = cvt_pk_bf16(v1[0], v1[1]); w.w = cvt_pk_bf16(v1[2], v1[3]);
                    *(u32x4*)(rowp + bj * HALF) = w; } }
    }
};
struct EpiSwiGLU {
    static constexpr bool PERM = true;
    bf16_t* O; int ldc;
    __device__ __forceinline__ void operator()(const Acc& acc, const Unit& u, int wr, int wc, int fr, int fq) const {
        const int row0 = wr * 64 + fr, col0 = wc * 32 + 8 * fq;
#pragma unroll
        for (int ai = 0; ai < 2; ++ai)
#pragma unroll
            for (int m = 0; m < 4; ++m) { bf16_t* rowp = O + u.c + (long)(row0 + ai * HALF + m * 16) * ldc + col0;
                float r[8];
#pragma unroll
                for (int n = 0; n < 2; ++n)
#pragma unroll
                    for (int j = 0; j < 4; ++j) { const float g = acc[ai][0][m][n][j], up = acc[ai][1][m][n][j]; r[n * 4 + j] = g * fsigmoid(g) * up; }
                u32x4 w; w.x = cvt_pk_bf16(r[0], r[1]); w.y = cvt_pk_bf16(r[2], r[3]); w.z = cvt_pk_bf16(r[4], r[5]); w.w = cvt_pk_bf16(r[6], r[7]);
                *(u32x4*)rowp = w; }
    }
};
struct EpiGLU {
    static constexpr bool PERM = false;
    float* C; int ldc;
    __device__ __forceinline__ void operator()(const Acc& acc, const Unit& u, int wr, int wc, int fr, int fq) const {
        const int row0 = wr * 64 + fr, col0 = wc * 32 + 4 * fq;
#pragma unroll
        for (int ai = 0; ai < 2; ++ai)
#pragma unroll
            for (int m = 0; m < 4; ++m) { float* rowp = C + u.c + (long)(row0 + ai * HALF + m * 16) * ldc + col0;
#pragma unroll
                for (int n = 0; n < 2; ++n) { f32x4 o;
#pragma unroll
                    for (int j = 0; j < 4; ++j) o[j] = acc[ai][0][m][n][j] * fsigmoid(acc[ai][1][m][n][j]);
                    *(f32x4*)(rowp + n * 16) = o; } }
    }
};
struct EpiS5U {
    static constexpr bool PERM = true;
    bf16_t* Ub;
    __device__ __forceinline__ void operator()(const Acc& acc, const Unit& u, int wr, int wc, int fr, int fq) const {
#pragma unroll
        for (int ai = 0; ai < 2; ++ai)
#pragma unroll
            for (int m = 0; m < 4; ++m) { const int tok = u.i0 * 256 + ai * HALF + wr * 64 + m * 16 + fr;
#pragma unroll
                for (int bj = 0; bj < 2; ++bj) { const int g = u.i1 * 16 + 8 * bj + 2 * wc + (fq >> 1);
                    bf16_t* dst = Ub + (long)g * USTRIDE + (long)(tok >> 4) * UK + (tok & 15) * 16 + (fq & 1) * 8;
                    const f32x4 v0 = acc[ai][bj][m][0], v1 = acc[ai][bj][m][1];
                    u32x4 w; w.x = cvt_pk_bf16(v0[0], v0[1]); w.y = cvt_pk_bf16(v0[2], v0[3]); w.z = cvt_pk_bf16(v1[0], v1[1]); w.w = cvt_pk_bf16(v1[2], v1[3]);
                    *(u32x4*)dst = w; } }
    }
};
struct EpiS5S {
    static constexpr bool PERM = false;
    float* Sb;
    __device__ __forceinline__ void operator()(const Acc& acc, const Unit& u, int wr, int wc, int fr, int fq) const {
#pragma unroll
        for (int ai = 0; ai < 2; ++ai)
#pragma unroll
            for (int m = 0; m < 4; ++m) { const int row = u.i0 * 256 + ai * HALF + wr * 64 + m * 16 + fr;
                if (row < CR) { float* rowp = Sb + ((long)u.i1 * CR + row) * 128 + wc * 32 + 4 * fq;
#pragma unroll
                    for (int n = 0; n < 2; ++n) *(f32x4*)(rowp + n * 16) = acc[ai][0][m][n]; } }
    }
};
struct EpiS5D {
    static constexpr bool PERM = true;
    const bf16_t* Ub; const float* dvec; bf16_t* Zb;
    __device__ __forceinline__ void operator()(const Acc& acc, const Unit& u, int wr, int wc, int fr, int fq) const {
        const int g = u.i1, c0 = (fq & 1) * 8;
        const f32x4 d0 = *(const f32x4*)(dvec + g * 16 + c0), d1 = *(const f32x4*)(dvec + g * 16 + c0 + 4);
#pragma unroll
        for (int ai = 0; ai < 2; ++ai)
#pragma unroll
            for (int m = 0; m < 4; ++m) { const int row = u.i0 * 256 + ai * HALF + wr * 64 + m * 16 + fr;
                if (row < CR) {
#pragma unroll
                    for (int bj = 0; bj < 2; ++bj) { const int jt = 8 * bj + 2 * wc + (fq >> 1);
                        const u32x4 uu = *(const u32x4*)(Ub + (long)g * USTRIDE + (long)row * UK + jt * 16 + c0);
                        float y[8];
#pragma unroll
                        for (int q = 0; q < 4; ++q) { const unsigned w = uu[q]; const float ulo = __uint_as_float(w << 16), uhi = __uint_as_float(w & 0xffff0000u);
                            const float dl = (q < 2) ? d0[2 * q] : d1[2 * q - 4], dh = (q < 2) ? d0[2 * q + 1] : d1[2 * q - 3];
                            const float al = (q < 2) ? acc[ai][bj][m][0][2 * q] : acc[ai][bj][m][1][2 * q - 4], ah = (q < 2) ? acc[ai][bj][m][0][2 * q + 1] : acc[ai][bj][m][1][2 * q - 3];
                            y[2 * q] = gelu_tanh(al + dl * ulo); y[2 * q + 1] = gelu_tanh(ah + dh * uhi); }
                        u32x4 w; w.x = cvt_pk_bf16(y[0], y[1]); w.y = cvt_pk_bf16(y[2], y[3]); w.z = cvt_pk_bf16(y[4], y[5]); w.w = cvt_pk_bf16(y[6], y[7]);
                        *(u32x4*)(Zb + (long)(row * 16 + jt) * D + g * 16 + c0) = w; } } }
    }
};
struct EpiSoftmax {
    static constexpr bool PERM = true;
    bf16_t* O; int ldc; LAS float* Xl;
    __device__ __forceinline__ void operator()(const Acc& acc, const Unit& u, int wr, int wc, int fr, int fq) const {
        float mx[2][4]; const int ln = fr + 16 * fq;
#pragma unroll
        for (int ai = 0; ai < 2; ++ai)
#pragma unroll
            for (int m = 0; m < 4; ++m) { float a = -3.0e38f;
#pragma unroll
                for (int bj = 0; bj < 2; ++bj)
#pragma unroll
                    for (int n = 0; n < 2; ++n)
#pragma unroll
                        for (int j = 0; j < 4; ++j) a = fmaxf(a, acc[ai][bj][m][n][j]);
                a = fmaxf(a, shx(a, 16, ln)); a = fmaxf(a, shx(a, 32, ln));
                float s = 0.f;
#pragma unroll
                for (int bj = 0; bj < 2; ++bj)
#pragma unroll
                    for (int n = 0; n < 2; ++n)
#pragma unroll
                        for (int j = 0; j < 4; ++j) s += __expf(acc[ai][bj][m][n][j] - a);
                s += shx(s, 16, ln); s += shx(s, 32, ln);
                mx[ai][m] = a;
                const int r = ai * HALF + wr * 64 + m * 16 + fr;
                if (fq == 0) { Xl[(r * 4 + wc) * 2] = a; Xl[(r * 4 + wc) * 2 + 1] = s; } }
        asm volatile("s_waitcnt lgkmcnt(0)" ::: "memory"); __builtin_amdgcn_s_barrier(); asm volatile("" ::: "memory");
#pragma unroll
        for (int ai = 0; ai < 2; ++ai)
#pragma unroll
            for (int m = 0; m < 4; ++m) { const int r = ai * HALF + wr * 64 + m * 16 + fr;
                const f32x4 p0 = *(const LAS f32x4*)(Xl + r * 8), p1 = *(const LAS f32x4*)(Xl + r * 8 + 4);
                const float M = fmaxf(fmaxf(p0[0], p0[2]), fmaxf(p1[0], p1[2]));
                const float Ls = p0[1] * __expf(p0[0] - M) + p0[3] * __expf(p0[2] - M) + p1[1] * __expf(p1[0] - M) + p1[3] * __expf(p1[2] - M);
                const float inv = __builtin_amdgcn_rcpf(Ls);
                bf16_t* rowp = O + u.c + (long)r * ldc + wc * 32 + 8 * fq;
#pragma unroll
                for (int bj = 0; bj < 2; ++bj) { float e[8];
#pragma unroll
                    for (int n = 0; n < 2; ++n)
#pragma unroll
                        for (int j = 0; j < 4; ++j) e[n * 4 + j] = __expf(acc[ai][bj][m][n][j] - M) * inv;
                    u32x4 w; w.x = cvt_pk_bf16(e[0], e[1]); w.y = cvt_pk_bf16(e[2], e[3]); w.z = cvt_pk_bf16(e[4], e[5]); w.w = cvt_pk_bf16(e[6], e[7]);
                    *(u32x4*)(rowp + bj * HALF) = w; } }
        (void)mx;
    }
};

template <class Epi>
__device__ __forceinline__ void gemm_run(LAS unsigned char* lds, const GD g, const Epi& E, int rot) {
    const int tid = opaque_tid(), wid = __builtin_amdgcn_readfirstlane(tid >> 6), lane = tid & 63, wr = wid >> 2, wc = wid & 3, fr = lane & 15, fq = lane >> 4;
    const int nt = g.nt, G = gridDim.x;
    int cblk = blockIdx.x; asm volatile("" : "+s"(cblk)); cblk += rot; if (cblk >= G) cblk -= G;
    unsigned voffA[2], voffB[2];
#pragma unroll
    for (int i = 0; i < 2; ++i) { int R, C; stage_rc(tid * 16 + i * 8192, R, C); const int Rb = Epi::PERM ? ((R & ~31) + perm32(R & 31)) : R;
        voffA[i] = (unsigned)(R * g.lda + C) * 2u; voffB[i] = (unsigned)(Rb * g.ldb + C) * 2u; }
    const size_t kstep = (size_t)(BK * 2);
    const size_t hstepA = (size_t)HALF * g.lda * 2, hstepB = (size_t)HALF * g.ldb * 2;
    const unsigned ldsw = (unsigned)wid * 1024u;
    const int aoff = lds_byte(wr * 64 + fr, fq * 8), boff = lds_byte(wc * 32 + fr, fq * 8);
#define PG8_SA(b, h) (((b) * 2 + (h)) * HTB)
#define PG8_SB(b, h) ((4 + (b) * 2 + (h)) * HTB)
#define PG8_STAGE(bufoff, gbase, voff) do { _Pragma("unroll") for (int _i = 0; _i < 2; ++_i) \
        __builtin_amdgcn_global_load_lds((const unsigned*)((const char*)(gbase) + (voff)[_i]), (LAS unsigned*)(lds + (bufoff) + ldsw + _i * 8192), 16, 0, 0); } while (0)
#define PG8_LDA(dst, b, h) do { _Pragma("unroll") for (int m = 0; m < 4; ++m) _Pragma("unroll") for (int k = 0; k < 2; ++k) dst[m][k] = *(const LAS bf16x8*)(lds + PG8_SA(b, h) + aoff + m * 2048 + k * 1024); } while (0)
#define PG8_LDB(dst, b, h) do { _Pragma("unroll") for (int n = 0; n < 2; ++n) _Pragma("unroll") for (int k = 0; k < 2; ++k) dst[n][k] = *(const LAS bf16x8*)(lds + PG8_SB(b, h) + boff + n * 2048 + k * 1024); } while (0)
#define PG8_MMA(ai, bj, At, Bt) do { __builtin_amdgcn_s_setprio(1); _Pragma("unroll") for (int m = 0; m < 4; ++m) _Pragma("unroll") for (int n = 0; n < 2; ++n) _Pragma("unroll") for (int k = 0; k < 2; ++k) \
        acc[ai][bj][m][n] = __builtin_amdgcn_mfma_f32_16x16x32_bf16(Bt[n][k], At[m][k], acc[ai][bj][m][n], 0, 0, 0); __builtin_amdgcn_s_setprio(0); } while (0)
#define PG8_WAIT_V(n) asm volatile("s_waitcnt vmcnt(" #n ")" ::: "memory")
#define PG8_WAIT_L(n) asm volatile("s_waitcnt lgkmcnt(" #n ")" ::: "memory")
#define PG8_BAR __builtin_amdgcn_s_barrier()
#define PG8_SCHED __builtin_amdgcn_sched_barrier(0)
    Unit cur, nxt; int ui = 0;
    if (!g.unit(cblk, cur)) return;
    Acc acc;
#pragma unroll
    for (int a = 0; a < 2; ++a)
#pragma unroll
        for (int b = 0; b < 2; ++b)
#pragma unroll
            for (int m = 0; m < 4; ++m)
#pragma unroll
                for (int n = 0; n < 2; ++n) acc[a][b][m][n] = (f32x4){0.f, 0.f, 0.f, 0.f};
    bf16x8 At[4][2], B0[2][2], B1[2][2];
    const char* cA = cur.a; const char* cB = cur.b;
    PG8_STAGE(PG8_SB(0, 0), cB, voffB); PG8_STAGE(PG8_SA(0, 0), cA, voffA); PG8_STAGE(PG8_SB(0, 1), cB + hstepB, voffB); PG8_STAGE(PG8_SA(0, 1), cA + hstepA, voffA);
    if (wr == 1) PG8_BAR;
    PG8_WAIT_V(4); PG8_BAR;
    PG8_STAGE(PG8_SB(1, 0), cB + kstep, voffB); PG8_STAGE(PG8_SA(1, 0), cA + kstep, voffA); PG8_STAGE(PG8_SB(1, 1), cB + hstepB + kstep, voffB);
    PG8_WAIT_V(6); PG8_BAR;
    for (;;) {
        const bool has_next = g.unit((long)(ui + 1) * G + cblk, nxt);
        const char* nA = has_next ? nxt.a : cA; const char* nB = has_next ? nxt.b : cB;
        for (int t = 0; t < nt; t += 2) {
            const bool last = (t == nt - 2);
            const char* a1 = cA + (size_t)(t + 1) * kstep;
            const char* a2 = last ? nA : cA + (size_t)(t + 2) * kstep; const char* b2 = last ? nB : cB + (size_t)(t + 2) * kstep;
            const char* a3 = a2 + kstep; const char* b3 = b2 + kstep;
            PG8_LDB(B0, 0, 0); PG8_SCHED; PG8_LDA(At, 0, 0); PG8_STAGE(PG8_SA(1, 1), a1 + hstepA, voffA);
            PG8_WAIT_L(8); PG8_BAR; PG8_WAIT_L(0); PG8_MMA(0, 0, At, B0); PG8_BAR; PG8_SCHED;
            PG8_LDB(B1, 0, 1); PG8_STAGE(PG8_SB(0, 0), b2, voffB);
            PG8_BAR; PG8_WAIT_L(0); PG8_MMA(0, 1, At, B1); PG8_BAR;
            PG8_LDA(At, 0, 1); PG8_STAGE(PG8_SA(0, 0), a2, voffA);
            PG8_BAR; PG8_WAIT_L(0); PG8_MMA(1, 0, At, B0); PG8_BAR; PG8_SCHED;
            PG8_STAGE(PG8_SB(0, 1), b2 + hstepB, voffB);
            PG8_WAIT_V(6); PG8_BAR; PG8_MMA(1, 1, At, B1); PG8_BAR;
            PG8_LDB(B0, 1, 0); PG8_SCHED; PG8_LDA(At, 1, 0); PG8_STAGE(PG8_SA(0, 1), a2 + hstepA, voffA);
            PG8_WAIT_L(8); PG8_BAR; PG8_WAIT_L(0); PG8_MMA(0, 0, At, B0); PG8_BAR; PG8_SCHED;
            PG8_LDB(B1, 1, 1); PG8_STAGE(PG8_SB(1, 0), b3, voffB);
            PG8_BAR; PG8_WAIT_L(0); PG8_MMA(0, 1, At, B1); PG8_BAR;
            PG8_LDA(At, 1, 1); PG8_STAGE(PG8_SA(1, 0), a3, voffA);
            PG8_BAR; PG8_WAIT_L(0); PG8_MMA(1, 0, At, B0); PG8_BAR; PG8_SCHED;
            PG8_STAGE(PG8_SB(1, 1), b3 + hstepB, voffB);
            PG8_WAIT_V(6); PG8_BAR; PG8_MMA(1, 1, At, B1); PG8_BAR;
        }
        E(acc, cur, wr, wc, fr, fq);
        if (!has_next) break;
#pragma unroll
        for (int a = 0; a < 2; ++a)
#pragma unroll
            for (int b = 0; b < 2; ++b)
#pragma unroll
                for (int m = 0; m < 4; ++m)
#pragma unroll
                    for (int n = 0; n < 2; ++n) acc[a][b][m][n] = (f32x4){0.f, 0.f, 0.f, 0.f};
        cur = nxt; cA = nA; cB = nB; ++ui;
    }
    PG8_WAIT_V(0);
    if (wr == 0) PG8_BAR;
    PG8_BAR;
#undef PG8_SA
#undef PG8_SB
#undef PG8_STAGE
#undef PG8_LDA
#undef PG8_LDB
#undef PG8_MMA
#undef PG8_WAIT_V
#undef PG8_WAIT_L
#undef PG8_BAR
#undef PG8_SCHED
}

__device__ __forceinline__ void rows_phase(const float* xsrc, const float* f, const float* gpost, float w, const float* gpre, float* xdst, bf16_t* h, int r0, int r1) {
    const int tid = opaque_tid(); const int lane = tid & 63, gw = blockIdx.x * 8 + (tid >> 6), nw = gridDim.x * 8;
    for (int r = r0 + gw; r < r1; r += nw) {
        f32x4 xv[4];
#pragma unroll
        for (int k = 0; k < 4; ++k) xv[k] = *(const f32x4*)(xsrc + (long)r * D + k * 256 + lane * 4);
        if (f) {
            f32x4 fv[4]; float ss = 0.f;
#pragma unroll
            for (int k = 0; k < 4; ++k) { fv[k] = *(const f32x4*)(f + (long)r * D + k * 256 + lane * 4); ss += fv[k][0] * fv[k][0] + fv[k][1] * fv[k][1] + fv[k][2] * fv[k][2] + fv[k][3] * fv[k][3]; }
            ss = wave_sum(ss, lane);
            const float rs = w * rsqrtf(ss * (1.0f / D) + EPS);
#pragma unroll
            for (int k = 0; k < 4; ++k) { const f32x4 gp = *(const f32x4*)(gpost + k * 256 + lane * 4); xv[k] = xv[k] + fv[k] * gp * rs; }
        }
        if (xdst) {
#pragma unroll
            for (int k = 0; k < 4; ++k) *(f32x4*)(xdst + (long)r * D + k * 256 + lane * 4) = xv[k];
        }
        if (h) {
            float ss = 0.f;
#pragma unroll
            for (int k = 0; k < 4; ++k) ss += xv[k][0] * xv[k][0] + xv[k][1] * xv[k][1] + xv[k][2] * xv[k][2] + xv[k][3] * xv[k][3];
            ss = wave_sum(ss, lane);
            const float rs = rsqrtf(ss * (1.0f / D) + EPS);
#pragma unroll
            for (int k = 0; k < 4; ++k) { const f32x4 gp = *(const f32x4*)(gpre + k * 256 + lane * 4); const f32x4 o = xv[k] * gp * rs;
                u32x2 wv; wv.x = cvt_pk_bf16(o[0], o[1]); wv.y = cvt_pk_bf16(o[2], o[3]); *(u32x2*)(h + (long)r * D + k * 256 + lane * 4) = wv; }
        }
    }
}

__device__ __forceinline__ void tconv_phase(const Params& p, unsigned char* shm) {
    bf16_t* tile = (bf16_t*)shm;
    const int tid = opaque_tid();
    for (int T = blockIdx.x; T < p.ntiles; T += gridDim.x) {
        int j = 0;
#pragma unroll 1
        for (int q = 1; q < NJOBS; ++q) if (T >= p.jobs[q].tile0) j = q;
        const TJob jb = p.jobs[j];
        int t = T - jb.tile0; const int per = jb.tr * jb.tc; const int b = t / per; t -= b * per; const int tr = t / jb.tc, tc = t % jb.tc;
        const float* src = jb.src + (long)b * jb.sbs; bf16_t* dst = jb.dst + (long)b * jb.dbs;
        const int R0 = tr * 64, C0 = tc * 64;
        { const int r = tid >> 3, c8 = (tid & 7) * 8;
          const f32x4 v0 = *(const f32x4*)(src + (long)(R0 + r) * jb.lds + C0 + c8), v1 = *(const f32x4*)(src + (long)(R0 + r) * jb.lds + C0 + c8 + 4);
          if (jb.mode == 3) { u32x4 w; w.x = cvt_pk_bf16(v0[0], v0[1]); w.y = cvt_pk_bf16(v0[2], v0[3]); w.z = cvt_pk_bf16(v1[0], v1[1]); w.w = cvt_pk_bf16(v1[2], v1[3]);
              *(u32x4*)(dst + (long)(R0 + r) * jb.ldd + C0 + c8) = w; continue; }
          const unsigned a0 = cvt_pk_bf16(v0[0], v0[1]), a1 = cvt_pk_bf16(v0[2], v0[3]), a2 = cvt_pk_bf16(v1[0], v1[1]), a3 = cvt_pk_bf16(v1[2], v1[3]);
          tile[(c8 + 0) * 72 + r] = (bf16_t)(a0 & 0xffff); tile[(c8 + 1) * 72 + r] = (bf16_t)(a0 >> 16);
          tile[(c8 + 2) * 72 + r] = (bf16_t)(a1 & 0xffff); tile[(c8 + 3) * 72 + r] = (bf16_t)(a1 >> 16);
          tile[(c8 + 4) * 72 + r] = (bf16_t)(a2 & 0xffff); tile[(c8 + 5) * 72 + r] = (bf16_t)(a2 >> 16);
          tile[(c8 + 6) * 72 + r] = (bf16_t)(a3 & 0xffff); tile[(c8 + 7) * 72 + r] = (bf16_t)(a3 >> 16); }
        __syncthreads();
        { const int c = tid >> 3, r8 = (tid & 7) * 8; const int cc = C0 + c;
          int drow = cc; if (jb.mode == 1) drow = (cc >> 7) * 256 + (cc & 127); else if (jb.mode == 2) drow = (cc >> 7) * 256 + 128 + (cc & 127);
          const u32x4 w = *(const u32x4*)(tile + c * 72 + r8);
          *(u32x4*)(dst + (long)drow * jb.ldd + R0 + r8) = w; }
        __syncthreads();
    }
}

__device__ __forceinline__ void lam_pow(const Params& p, int j, int g, int pp, int n, float& re, float& im) {
    const double dt = exp((double)p.in[26][j * 64 + g]);
    const long gp = ((long)j * 64 + g) * 64 + pp;
    const double lr = (double)p.in[19][gp] * dt * n, li = (double)p.in[20][gp] * dt * n;
    const double red = li - 6.283185307179586476925 * rint(li * 0.15915494309189533577);
    const float mg = (float)exp(lr); float sn, cs; sincosf((float)red, &sn, &cs); re = mg * cs; im = mg * sn;
}
__device__ __forceinline__ void s5prep_phase(const Params& p, unsigned char* shm) {
    float* lamr = (float*)shm;
    float* lami = lamr + 17 * 64;
    float* Bbr = lami + 17 * 64;
    float* Bbi = Bbr + 1024;
    float* Ccr = Bbi + 1024;
    float* Cci = Ccr + 1024;
    float* Kt = Cci + 1024;
    const int tid = opaque_tid();
    bf16_t* TV = (bf16_t*)(p.ws + O_TV); bf16_t* W5 = (bf16_t*)(p.ws + O_W5);
    for (int job = blockIdx.x; job < 128; job += gridDim.x) {
        const int j = job >> 6, g = job & 63;
        __syncthreads();
        if (tid < 64) {
            const int pp = tid; const long gp = ((long)j * 64 + g) * 64 + pp;
            const float dt = expf(p.in[26][j * 64 + g]);
            const float are = p.in[19][gp], aim = p.in[20][gp];
            const float lr = are * dt, li = aim * dt;
            for (int t = 0; t <= 16; ++t) { const float mg = expf(lr * t); float sn, cs; sincosf(li * t, &sn, &cs); lamr[t * 64 + pp] = mg * cs; lami[t * 64 + pp] = mg * sn; }
            const float nr = lamr[64 + pp] - 1.0f, ni = lami[64 + pp]; const float den = are * are + aim * aim;
            const float cr = (nr * are + ni * aim) / den, ci = (ni * are - nr * aim) / den;
            for (int c = 0; c < 16; ++c) { const float br = p.in[21][gp * 16 + c], bi = p.in[22][gp * 16 + c];
                Bbr[pp * 16 + c] = cr * br - ci * bi; Bbi[pp * 16 + c] = cr * bi + ci * br; }
            float q0, q1, q2, q3; lam_pow(p, j, g, pp, 16, q0, q1); lam_pow(p, j, g, pp, 1024, q2, q3);
            *(f32x4*)((float*)(p.ws + O_LAM) + gp * 4) = (f32x4){q0, q1, q2, q3};
        }
        for (int e = tid; e < 1024; e += 512) { const long gi = ((long)j * 64 + g) * 1024 + e; Ccr[e] = p.in[23][gi]; Cci[e] = p.in[24][gi]; }
        __syncthreads();
        for (int o = tid; o < 4096; o += 512) { const int tau = o >> 8, c = (o >> 4) & 15, cp = o & 15; float s = 0.f;
            for (int pp = 0; pp < 64; ++pp) { const float clr = Ccr[c * 64 + pp] * lamr[tau * 64 + pp] - Cci[c * 64 + pp] * lami[tau * 64 + pp];
                const float cli = Ccr[c * 64 + pp] * lami[tau * 64 + pp] + Cci[c * 64 + pp] * lamr[tau * 64 + pp];
                s += clr * Bbr[pp * 16 + cp] - cli * Bbi[pp * 16 + cp]; }
            Kt[o] = s; }
        __syncthreads();
        bf16_t* tv = TV + ((long)j * 64 + g) * 256 * UK;
        for (int e = tid; e < 256 * (UK / 2); e += 512) { const int n = e / (UK / 2), k = (e % (UK / 2)) * 2; const int jj = n >> 4, c = n & 15; float v[2];
#pragma unroll
            for (int q = 0; q < 2; ++q) { const int kk = k + q;
                if (kk < 256) { const int i = kk >> 4, cp = kk & 15; v[q] = (i <= jj) ? Kt[(jj - i) * 256 + c * 16 + cp] : 0.f; }
                else if (kk < 320) { const int pp = kk - 256; v[q] = Ccr[c * 64 + pp] * lamr[(jj + 1) * 64 + pp] - Cci[c * 64 + pp] * lami[(jj + 1) * 64 + pp]; }
                else { const int pp = kk - 320; v[q] = -(Ccr[c * 64 + pp] * lami[(jj + 1) * 64 + pp] + Cci[c * 64 + pp] * lamr[(jj + 1) * 64 + pp]); } }
            *(unsigned*)(tv + (long)n * UK + k) = cvt_pk_bf16(v[0], v[1]); }
        bf16_t* w5 = W5 + ((long)j * 64 + g) * 128 * 256;
        for (int e = tid; e < 128 * 128; e += 512) { const int n = e >> 7, k = (e & 127) * 2; const int pp = n & 63; const bool im = n >= 64; float v[2];
#pragma unroll
            for (int q = 0; q < 2; ++q) { const int kk = k + q, i = kk >> 4, cp = kk & 15; const int t = 15 - i;
                const float re = lamr[t * 64 + pp] * Bbr[pp * 16 + cp] - lami[t * 64 + pp] * Bbi[pp * 16 + cp];
                const float ii = lamr[t * 64 + pp] * Bbi[pp * 16 + cp] + lami[t * 64 + pp] * Bbr[pp * 16 + cp];
                v[q] = im ? ii : re; }
            *(unsigned*)(w5 + (long)n * 256 + k) = cvt_pk_bf16(v[0], v[1]); }
    }
    __syncthreads();
}

__device__ __forceinline__ void scan_phase(const Params& p, int j, unsigned char* shm) {
    float* E = (float*)shm;
    const int tid = opaque_tid();
    const float* S = (const float*)(p.ws + O_S); bf16_t* U = (bf16_t*)(p.ws + O_U);
    for (int item = blockIdx.x; item < 128; item += gridDim.x) {
        const int seq = item >> 6, g = item & 63, pp = tid & 63, sc = tid >> 6;
        const f32x4 lq = *(const f32x4*)((const float*)(p.ws + O_LAM) + (((long)j * 64 + g) * 64 + pp) * 4); const float ar = lq[0], ai = lq[1], br = lq[2], bi = lq[3];
        const int row0 = seq * 512 + sc * 64;
        const float* Sg = S + ((long)g * CR + row0) * 128 + pp;
        float er = 0.f, ei = 0.f;
#pragma unroll 8
        for (int k = 0; k < 64; ++k) { const float sr = Sg[k * 128], si = Sg[k * 128 + 64]; const float nr = ar * er - ai * ei + sr, ni = ar * ei + ai * er + si; er = nr; ei = ni; }
        __syncthreads();
        E[(sc * 64 + pp) * 2] = er; E[(sc * 64 + pp) * 2 + 1] = ei;
        __syncthreads();
        float hr = 0.f, hi = 0.f;
        for (int m = 0; m < sc; ++m) { const float xr = E[(m * 64 + pp) * 2], xi = E[(m * 64 + pp) * 2 + 1]; const float nr = br * hr - bi * hi + xr, ni = br * hi + bi * hr + xi; hr = nr; hi = ni; }
        bf16_t* Ug = U + (long)g * USTRIDE + (long)row0 * UK + 256 + pp;
#pragma unroll 8
        for (int k = 0; k < 64; ++k) { const float sr = Sg[k * 128], si = Sg[k * 128 + 64];
            Ug[k * UK] = (bf16_t)(cvt_pk_bf16(hr, 0.f) & 0xffff); Ug[k * UK + 64] = (bf16_t)(cvt_pk_bf16(hi, 0.f) & 0xffff);
            const float nr = ar * hr - ai * hi + sr, ni = ar * hi + ai * hr + si; hr = nr; hi = ni; }
        if (sc == 7) { const long o = (((long)j * 2 + seq) * 64 + g) * 64 + pp; p.out[OO_SRP + o] = hr; p.out[OO_SIP + o] = hi; }
    }
    { const int lane = tid & 63, gw = blockIdx.x * 8 + (tid >> 6), nw = gridDim.x * 8;
      for (int item = gw; item < 512; item += nw) { const int s = item >> 6, g = item & 63, pp = lane;
          const f32x4 lq = *(const f32x4*)((const float*)(p.ws + O_LAM) + (((long)j * 64 + g) * 64 + pp) * 4); const float ar = lq[0], ai = lq[1];
          const long si = (((long)j * 8 + s) * 64 + g) * 64 + pp;
          float hr = p.in[4][si], hi = p.in[5][si];
          const int row0 = 1024 + 2 * s;
          const float* Sg = S + ((long)g * CR + row0) * 128 + pp;
          bf16_t* Ug = U + (long)g * USTRIDE + (long)row0 * UK + 256 + pp;
#pragma unroll
          for (int k = 0; k < 2; ++k) { const float sr = Sg[k * 128], sim = Sg[k * 128 + 64];
              Ug[k * UK] = (bf16_t)(cvt_pk_bf16(hr, 0.f) & 0xffff); Ug[k * UK + 64] = (bf16_t)(cvt_pk_bf16(hi, 0.f) & 0xffff);
              const float nr = ar * hr - ai * hi + sr, ni = ar * hi + ai * hr + sim; hr = nr; hi = ni; }
          p.out[OO_SRS + si] = hr; p.out[OO_SIS + si] = hi; } }
}

__device__ __forceinline__ f32x4 pool_row(const float* F, const float* hist, int base, int t, int col) {
    if (t >= 0) return *(const f32x4*)(F + (long)(base + t) * D + col);
    if (hist) return *(const f32x4*)(hist + (long)(15 + t) * D + col);
    return (f32x4){0.f, 0.f, 0.f, 0.f};
}
__device__ __forceinline__ void pool_phase(const Params& p, int j) {
    const float* F = (const float*)(p.ws + O_F); bf16_t* Z = (bf16_t*)(p.ws + O_Z);
    const int tid = opaque_tid(); const int lane = tid & 63, gw = blockIdx.x * 8 + (tid >> 6), nw = gridDim.x * 8;
    for (int item = gw; item < 520 * 4; item += nw) {
        const int seg = item >> 2, grp = item & 3; const int W = 2 << grp; const int col = grp * 256 + lane * 4;
        const int tok0 = seg * 32;
        int base, t0, pos0; const float* hist = nullptr;
        if (tok0 < TP) { base = (tok0 >> 13) << 13; t0 = tok0 - base; pos0 = 0; }
        else { const int s = (tok0 - TP) >> 5; base = tok0; t0 = 0; pos0 = 1024; hist = p.in[6] + ((long)j * 8 + s) * 15 * D; }
        f32x4 sum = (f32x4){0.f, 0.f, 0.f, 0.f};
        for (int k = 1; k < W; ++k) sum = sum + pool_row(F, hist, base, t0 - k, col);
        for (int i = 0; i < 32; ++i) { const int t = t0 + i; const f32x4 u = *(const f32x4*)(F + (long)(base + t) * D + col);
            sum = sum + u;
            const int cnt = min(pos0 + t + 1, W); const float inv = 1.0f / (float)cnt;
            const f32x4 o = sum * inv - u;
            u32x2 wv; wv.x = cvt_pk_bf16(o[0], o[1]); wv.y = cvt_pk_bf16(o[2], o[3]); *(u32x2*)(Z + (long)(base + t) * D + col) = wv;
            sum = sum - pool_row(F, hist, base, t - W + 1, col); }
    }
    for (int e = blockIdx.x * 512 + tid; e < 10 * 15 * 256; e += gridDim.x * 512) {
        const int c4 = (e & 255) * 4, r = (e >> 8) % 15, sq = (e >> 8) / 15;
        if (sq < 2) { const f32x4 v = *(const f32x4*)(F + (long)(sq * 8192 + 8177 + r) * D + c4); *(f32x4*)(p.out + OO_PP + (((long)j * 2 + sq) * 15 + r) * D + c4) = v; }
        else { const int s = sq - 2; const f32x4 v = *(const f32x4*)(F + (long)(TP + s * 32 + 17 + r) * D + c4); *(f32x4*)(p.out + OO_PS + (((long)j * 8 + s) * 15 + r) * D + c4) = v; }
    }
}

__device__ __forceinline__ void sample_attn_phase(const Params& p, int l, unsigned char* shm) {
    float* Ssm = (float*)shm;
    const int tid = opaque_tid(), wid = tid >> 6, lane = tid & 63, fr = lane & 15, fq = lane >> 4;
    const bf16_t* Q = (const bf16_t*)(p.ws + O_Z) + (long)TP * D; bf16_t* Oo = (bf16_t*)(p.ws + O_H) + (long)TP * D;
    for (int item = blockIdx.x; item < 32; item += gridDim.x) {
        const int b = item >> 2, h = item & 3;
        const float* Kc = p.in[2] + (((long)l * 8 + b) * 256) * D + h * 256;
        const float* Vc = p.in[3] + (((long)l * 8 + b) * 256) * D + h * 256;
        f32x4 acc[2][2];
#pragma unroll
        for (int a = 0; a < 2; ++a)
#pragma unroll
            for (int n = 0; n < 2; ++n) acc[a][n] = (f32x4){0.f, 0.f, 0.f, 0.f};
        for (int st = 0; st < 8; ++st) {
            bf16x8 af[2], bfr[2];
#pragma unroll
            for (int a = 0; a < 2; ++a) af[a] = *(const bf16x8*)(Q + (long)(b * 32 + a * 16 + fr) * D + h * 256 + st * 32 + fq * 8);
#pragma unroll
            for (int n = 0; n < 2; ++n) { const float* kp = Kc + (long)(wid * 32 + n * 16 + fr) * D + st * 32 + fq * 8;
                const f32x4 k0 = *(const f32x4*)kp, k1 = *(const f32x4*)(kp + 4);
                u32x4 w; w.x = cvt_pk_bf16(k0[0], k0[1]); w.y = cvt_pk_bf16(k0[2], k0[3]); w.z = cvt_pk_bf16(k1[0], k1[1]); w.w = cvt_pk_bf16(k1[2], k1[3]);
                bfr[n] = __builtin_bit_cast(bf16x8, w); }
#pragma unroll
            for (int a = 0; a < 2; ++a)
#pragma unroll
                for (int n = 0; n < 2; ++n) acc[a][n] = __builtin_amdgcn_mfma_f32_16x16x32_bf16(af[a], bfr[n], acc[a][n], 0, 0, 0);
        }
        __syncthreads();
#pragma unroll
        for (int a = 0; a < 2; ++a)
#pragma unroll
            for (int n = 0; n < 2; ++n)
#pragma unroll
                for (int jj = 0; jj < 4; ++jj) Ssm[(a * 16 + 4 * fq + jj) * 256 + wid * 32 + n * 16 + fr] = acc[a][n][jj] * 0.0625f;
        __syncthreads();
        for (int rr = 0; rr < 4; ++rr) { const int r = wid * 4 + rr; f32x4 v = *(const f32x4*)(Ssm + r * 256 + lane * 4);
            const float mxv = wave_max(fmaxf(fmaxf(v[0], v[1]), fmaxf(v[2], v[3])), lane);
            v[0] = __expf(v[0] - mxv); v[1] = __expf(v[1] - mxv); v[2] = __expf(v[2] - mxv); v[3] = __expf(v[3] - mxv);
            const float inv = 1.0f / wave_sum(v[0] + v[1] + v[2] + v[3], lane);
            *(f32x4*)(Ssm + r * 256 + lane * 4) = v * inv; }
        __syncthreads();
        { const int d = tid & 255, qh = tid >> 8; float o[16];
#pragma unroll
          for (int q = 0; q < 16; ++q) o[q] = 0.f;
          for (int m = 0; m < 256; m += 4) { const float v0 = Vc[(long)m * D + d], v1 = Vc[(long)(m + 1) * D + d], v2 = Vc[(long)(m + 2) * D + d], v3 = Vc[(long)(m + 3) * D + d];
#pragma unroll
              for (int q = 0; q < 16; ++q) { const f32x4 pv = *(const f32x4*)(Ssm + (qh * 16 + q) * 256 + m); o[q] += pv[0] * v0 + pv[1] * v1 + pv[2] * v2 + pv[3] * v3; } }
#pragma unroll
          for (int q = 0; q < 16; ++q) Oo[(long)(b * 32 + qh * 16 + q) * D + h * 256 + d] = (bf16_t)(cvt_pk_bf16(o[q], 0.f) & 0xffff); }
        __syncthreads();
    }
}

__global__ void __launch_bounds__(512, 2) mega(const Params p) {
    extern __shared__ __attribute__((aligned(16))) unsigned char shm[];
    cg::grid_group grid = cg::this_grid();
    LAS unsigned char* lds = (LAS unsigned char*)shm;
#define ws (opq_ptr(p.ws))
#define X ((float*)opq_ptr((unsigned char*)p.out))
#define H ((bf16_t*)(ws + O_H))
#define Z ((bf16_t*)(ws + O_Z))
#define F ((float*)(ws + O_F))
#define ACT ((bf16_t*)(ws + O_ACT))
#define U ((bf16_t*)(ws + O_U))
#define S ((float*)(ws + O_S))
#define npre ((const float*)opq_ptr((unsigned char*)p.in[8]))
#define npost ((const float*)opq_ptr((unsigned char*)p.in[9]))

    tconv_phase(p, shm);
    s5prep_phase(p, shm);
#pragma unroll 1
    for (int l = 0; l < 4; ++l) rows_phase(p.in[7], nullptr, nullptr, 0.f, p.in[10] + l * D, nullptr, (bf16_t*)(ws + O_AMEM) + (long)l * 512 * D, 0, 512);
    rows_phase(p.in[0], nullptr, nullptr, 0.f, npre, X, H, 0, TP);
    rows_phase(p.in[1] - (long)TP * D, nullptr, nullptr, 0.f, npre, X, H, TP, TT);
    grid.sync();
    { GD g = gd_zero(); g.A = (const bf16_t*)(ws + O_AMEM); g.B = (const bf16_t*)(ws + O_WKT); g.lda = D; g.ldb = D; g.nt = 16; g.n = 64; g.d0 = 2; g.d1 = 4; g.d2 = 4;
      g.sa[0] = (int)(256L * D); g.sa[2] = (int)(512L * D); g.sb[1] = (int)(256L * D); g.sb[2] = (int)(M1); g.sb[3] = (int)(4 * M1);
      g.sc[0] = (int)(256L * D); g.sc[1] = (int)(256); g.sc[2] = (int)(512L * D); g.sc[3] = (int)(2097152L);
      EpiF32Bf16 e; e.C = p.out + OO_MEMK; e.O = (bf16_t*)(ws + O_KBF); e.ldc = D;
      gemm_run(lds, g, e, 0); }
    grid.sync();
    { GD g = gd_zero(); g.A = (const bf16_t*)(ws + O_KBF); g.B = (const bf16_t*)(ws + O_WQP); g.lda = D; g.ldb = D; g.nt = 4; g.n = 128; g.d0 = 4; g.d1 = 4; g.d2 = 2;
      g.sa[1] = (int)(256); g.sa[2] = (int)(256L * D); g.sa[3] = (int)(512L * D); g.sb[0] = (int)(256L * D); g.sb[1] = (int)(256); g.sb[3] = (int)(M1);
      g.sc[0] = (int)(256); g.sc[1] = (int)(256L * D); g.sc[2] = (int)(M1); g.sc[3] = (int)(2 * M1);
      EpiBf16 e; e.O = (bf16_t*)(ws + O_QK); e.ldc = D; e.s = 0.0625f;
      gemm_run(lds, g, e, 0); }
    { GD g = gd_zero(); g.A = (const bf16_t*)(ws + O_WOT); g.B = (const bf16_t*)(ws + O_KBF) + 2097152L; g.lda = D; g.ldb = D; g.nt = 4; g.n = 128; g.d0 = 4; g.d1 = 4; g.d2 = 2;
      g.sa[0] = (int)(256L * D); g.sa[1] = (int)(256); g.sa[3] = (int)(M1); g.sb[1] = (int)(256); g.sb[2] = (int)(256L * D); g.sb[3] = (int)(512L * D);
      g.sc[0] = (int)(256L * D); g.sc[1] = (int)(256); g.sc[2] = (int)(M1); g.sc[3] = (int)(2 * M1);
      EpiBf16 e; e.O = (bf16_t*)(ws + O_VW); e.ldc = D; e.s = 1.0f;
      gemm_run(lds, g, e, 128); }
    grid.sync();

#pragma unroll 1
    for (int l = 0; l < 4; ++l) {
        const int j = l >> 1;
#pragma unroll 1
        for (int sub = 0; sub < 4; ++sub) {
            if (sub == 0 || sub == 3) {
                const int s = sub ? 1 : 0;
                { GD g = gd_plain(H, D, (const bf16_t*)(ws + O_WGU) + (long)(l * 2 + s) * 5632 * D, D, D, 65, 22, DFF, 128);
                  EpiSwiGLU e; e.O = ACT; e.ldc = DFF; gemm_run(lds, g, e, 0); }
                grid.sync();
                { GD g = gd_plain(ACT, DFF, (const bf16_t*)(ws + O_WDN) + (long)(l * 2 + s) * D * DFF, DFF, DFF, 65, 4, D, 256);
                  EpiF32 e; e.C = F; e.ldc = D; e.bias = nullptr; e.scale = nullptr; gemm_run(lds, g, e, 0); }
                grid.sync();
                const bool lastsub = (l == 3 && sub == 3);
                rows_phase(X, F, npost + (l * 4 + sub) * D, 0.5f, lastsub ? nullptr : npre + (sub == 0 ? (l * 4 + 1) : ((l + 1) * 4)) * D, X, lastsub ? nullptr : H, 0, TT);
                grid.sync();
            } else if (sub == 1) {
                if ((l & 1) == 0) {
                    { GD g = gd_plain(H, D, (const bf16_t*)(ws + O_WSI) + (long)j * M1, D, D, 65, 4, D, 256);
                      EpiS5U e; e.Ub = U; gemm_run(lds, g, e, 0); }
                    grid.sync();
                    { GD g = gd_zero(); g.A = U; g.B = (const bf16_t*)(ws + O_W5) + (long)j * 64 * 128 * 256; g.lda = UK; g.ldb = 256; g.nt = 4; g.n = 320; g.d0 = 5; g.d1 = 64; g.d2 = 1;
                      g.sa[0] = (int)(256L * UK); g.sa[1] = (int)(USTRIDE); g.sb[1] = (int)(128L * 256);
                      EpiS5S e; e.Sb = S; gemm_run(lds, g, e, 0); }
                    grid.sync();
                    scan_phase(p, j, shm);
                    grid.sync();
                    { GD g = gd_zero(); g.A = U; g.B = (const bf16_t*)(ws + O_TV) + (long)j * 64 * 256 * UK; g.lda = UK; g.ldb = UK; g.nt = 6; g.n = 320; g.d0 = 5; g.d1 = 64; g.d2 = 1;
                      g.sa[0] = (int)(256L * UK); g.sa[1] = (int)(USTRIDE); g.sb[1] = (int)(256L * UK);
                      EpiS5D e; e.Ub = U; e.dvec = p.in[25] + j * D; e.Zb = Z; gemm_run(lds, g, e, 0); }
                    grid.sync();
                    { GD g = gd_plain(Z, D, (const bf16_t*)(ws + O_WGL) + (long)j * 2048 * D, D, D, 65, 8, D, 128);
                      EpiGLU e; e.C = F; e.ldc = D; gemm_run(lds, g, e, 0); }
                    grid.sync();
                } else {
                    { GD g = gd_plain(H, D, (const bf16_t*)(ws + O_WPI) + (long)j * M1, D, D, 65, 4, D, 256);
                      EpiF32 e; e.C = F; e.ldc = D; e.bias = nullptr; e.scale = nullptr; gemm_run(lds, g, e, 0); }
                    grid.sync();
                    pool_phase(p, j);
                    grid.sync();
                    { GD g = gd_zero(); g.A = Z; g.B = (const bf16_t*)(ws + O_WGR) + (long)j * 4 * 65536; g.lda = D; g.ldb = 256; g.nt = 4; g.n = 260; g.d0 = 65; g.d1 = 4; g.d2 = 1;
                      g.sa[0] = (int)(256L * D); g.sa[1] = (int)(256); g.sb[1] = (int)(65536); g.sc[0] = (int)(256L * D); g.sc[1] = (int)(256);
                      EpiF32 e; e.C = F; e.ldc = D; e.bias = p.in[30] + j * D; e.scale = p.in[31] + j * D; gemm_run(lds, g, e, 0); }
                    grid.sync();
                }
                rows_phase(X, F, npost + (l * 4 + 1) * D, 1.0f, npre + (l * 4 + 2) * D, X, H, 0, TT);
                grid.sync();
            } else {
                { GD g = gd_zero(); g.A = H; g.B = (const bf16_t*)(ws + O_QK) + (long)l * 2 * M1; g.lda = D; g.ldb = D; g.nt = 16; g.n = 256; g.d0 = 32; g.d1 = 2; g.d2 = 4;
                  g.sa[0] = (int)(256L * D); g.sa[1] = (int)(32L * 256 * D); g.sb[1] = (int)(M1); g.sb[2] = (int)(256L * D); g.sc[0] = (int)(256L * D); g.sc[1] = (int)(32L * 256 * D); g.sc[2] = (int)(256);
                  EpiSoftmax e; e.O = Z; e.ldc = D; e.Xl = (LAS float*)(lds + LDS_X); gemm_run(lds, g, e, 0); }
                { GD g = gd_plain(H + (long)TP * D, D, (const bf16_t*)(ws + O_WQT) + (long)l * M1, D, D, 1, 4, D, 256);
                  EpiBf16 e; e.O = Z + (long)TP * D; e.ldc = D; e.s = 1.0f; gemm_run(lds, g, e, 0); }
                grid.sync();
                { GD g = gd_zero(); g.A = Z; g.B = (const bf16_t*)(ws + O_VW) + (long)l * 2 * M1; g.lda = D; g.ldb = D; g.nt = 16; g.n = 256; g.d0 = 32; g.d1 = 2; g.d2 = 4;
                  g.sa[0] = (int)(256L * D); g.sa[1] = (int)(32L * 256 * D); g.sb[1] = (int)(M1); g.sb[2] = (int)(256L * D); g.sc[0] = (int)(256L * D); g.sc[1] = (int)(32L * 256 * D); g.sc[2] = (int)(256);
                  EpiF32 e; e.C = F; e.ldc = D; e.bias = nullptr; e.scale = nullptr; gemm_run(lds, g, e, 0); }
                sample_attn_phase(p, l, shm);
                grid.sync();
                { GD g = gd_plain(H + (long)TP * D, D, (const bf16_t*)(ws + O_WOT) + (long)l * M1, D, D, 1, 4, D, 256);
                  EpiF32 e; e.C = F + (long)TP * D; e.ldc = D; e.bias = nullptr; e.scale = nullptr; gemm_run(lds, g, e, 0); }
                grid.sync();
                rows_phase(X, F, npost + (l * 4 + 2) * D, 1.0f, npre + (l * 4 + 3) * D, X, H, 0, TT);
                grid.sync();
            }
        }
    }
}
#undef ws
#undef X
#undef H
#undef Z
#undef F
#undef ACT
#undef U
#undef S
#undef npre
#undef npost

static void add_job(Params& p, int& nj, int& tiles, const float* src, bf16_t* dst, int R, int C, int lds, int ldd, int mode, int nb, long sbs, long dbs) {
    TJob& j = p.jobs[nj++]; j.src = src; j.dst = dst; j.sbs = sbs; j.dbs = dbs; j.lds = lds; j.ldd = ldd; j.tr = R / 64; j.tc = C / 64; j.mode = mode; j.nb = nb; j.tile0 = tiles; j.pad = 0;
    tiles += nb * j.tr * j.tc;
}

extern "C" void kernel_launch(void* const* d_in, const int* in_sizes, int n_in, void* d_out, int out_size, void* d_ws, size_t ws_size, hipStream_t stream) {
    static int grid_blocks = 0;
    if (grid_blocks == 0) {
        if (n_in != 32 || (long)out_size != OUT_TOTAL || ws_size < WS_END) {
            fprintf(stderr, "kernel_launch: unexpected shapes (n_in %d out %d ws %zu need %zu)\n", n_in, out_size, ws_size, (size_t)WS_END); grid_blocks = -1; return; }
        int dev = 0, cus = 0, per_cu = 0;
        hipGetDevice(&dev);
        hipDeviceGetAttribute(&cus, hipDeviceAttributeMultiprocessorCount, dev);
        if (hipFuncSetAttribute((const void*)mega, hipFuncAttributeMaxDynamicSharedMemorySize, LDS_BYTES) != hipSuccess) { fprintf(stderr, "kernel_launch: hipFuncSetAttribute failed\n"); grid_blocks = -1; return; }
        if (hipOccupancyMaxActiveBlocksPerMultiprocessor(&per_cu, (const void*)mega, 512, LDS_BYTES) != hipSuccess || per_cu < 1) { fprintf(stderr, "kernel_launch: occupancy query failed (%d)\n", per_cu); (void)hipGetLastError(); per_cu = 1; }
        grid_blocks = cus * per_cu;
    }
    if (grid_blocks < 0) return;
    Params p; memset(&p, 0, sizeof(p));
    for (int i = 0; i < 32; ++i) p.in[i] = (const float*)d_in[i];
    p.out = (float*)d_out; p.ws = (unsigned char*)d_ws;
    unsigned char* ws = (unsigned char*)d_ws;
    int nj = 0, tiles = 0;
    const long WF = 1024L * 2816;
    add_job(p, nj, tiles, p.in[11], (bf16_t*)(ws + O_WGU), 1024, 2816, 2816, 1024, 1, 8, WF, 5632L * 1024);
    add_job(p, nj, tiles, p.in[12], (bf16_t*)(ws + O_WGU), 1024, 2816, 2816, 1024, 2, 8, WF, 5632L * 1024);
    add_job(p, nj, tiles, p.in[13], (bf16_t*)(ws + O_WDN), 2816, 1024, 1024, 2816, 0, 8, WF, WF);
    add_job(p, nj, tiles, p.in[14], (bf16_t*)(ws + O_WQT), 1024, 1024, 1024, 1024, 0, 4, M1, M1);
    add_job(p, nj, tiles, p.in[14], (bf16_t*)(ws + O_WQP), 1024, 1024, 1024, 1024, 3, 4, M1, M1);
    add_job(p, nj, tiles, p.in[15], (bf16_t*)(ws + O_WKT), 1024, 1024, 1024, 1024, 0, 4, M1, M1);
    add_job(p, nj, tiles, p.in[16], (bf16_t*)(ws + O_WKT) + 4 * M1, 1024, 1024, 1024, 1024, 0, 4, M1, M1);
    add_job(p, nj, tiles, p.in[17], (bf16_t*)(ws + O_WOT), 1024, 1024, 1024, 1024, 0, 4, M1, M1);
    add_job(p, nj, tiles, p.in[18], (bf16_t*)(ws + O_WSI), 1024, 1024, 1024, 1024, 0, 2, M1, M1);
    add_job(p, nj, tiles, p.in[27], (bf16_t*)(ws + O_WGL), 1024, 1024, 2048, 1024, 1, 2, 2 * M1, 2 * M1);
    add_job(p, nj, tiles, p.in[27] + 1024, (bf16_t*)(ws + O_WGL), 1024, 1024, 2048, 1024, 2, 2, 2 * M1, 2 * M1);
    add_job(p, nj, tiles, p.in[28], (bf16_t*)(ws + O_WPI), 1024, 1024, 1024, 1024, 0, 2, M1, M1);
    add_job(p, nj, tiles, p.in[29], (bf16_t*)(ws + O_WGR), 256, 256, 256, 256, 0, 8, 65536, 65536);
    while (nj < NJOBS) { TJob& j = p.jobs[nj++]; j.tile0 = 0x7fffffff; j.tr = 1; j.tc = 1; j.nb = 0; }
    p.ntiles = tiles;
    void* args[] = {(void*)&p};
    hipError_t e = hipLaunchCooperativeKernel((const void*)mega, dim3(grid_blocks), dim3(512), args, LDS_BYTES, stream);
    if (e != hipSuccess) fprintf(stderr, "cooperative launch failed: %s (grid %d)\n", hipGetErrorString(e), grid_blocks);
}
```

```cpp
#include <hip/hip_runtime.h>
#include <hip/hip_cooperative_groups.h>
#include <cstdio>
#include <cstring>
namespace cg = cooperative_groups;

#define LAS __attribute__((address_space(3)))
typedef unsigned short bf16_t;
typedef short bf16x8 __attribute__((ext_vector_type(8)));
typedef float f32x4 __attribute__((ext_vector_type(4)));
typedef unsigned u32x4 __attribute__((ext_vector_type(4)));
typedef unsigned u32x2 __attribute__((ext_vector_type(2)));

constexpr int D = 1024, DFF = 2816, TP = 16384, TT = 16640;
constexpr int CR = 1040, UK = 384;
constexpr long USTRIDE = (long)CR * UK;
constexpr float EPS = 1e-6f;
constexpr long M1 = 1024 * 1024;

constexpr size_t AL(size_t x) { return (x + 255) & ~(size_t)255; }
constexpr size_t O_WGU = 0;
constexpr size_t O_WDN = O_WGU + AL((size_t)8 * 5632 * 1024 * 2);
constexpr size_t O_WQT = O_WDN + AL((size_t)8 * 1024 * 2816 * 2);
constexpr size_t O_WOT = O_WQT + AL((size_t)4 * M1 * 2);
constexpr size_t O_WSI = O_WOT + AL((size_t)4 * M1 * 2);
constexpr size_t O_WPI = O_WSI + AL((size_t)2 * M1 * 2);
constexpr size_t O_WGL = O_WPI + AL((size_t)2 * M1 * 2);
constexpr size_t O_WGR = O_WGL + AL((size_t)2 * 2048 * 1024 * 2);
constexpr size_t O_TV  = O_WGR + AL((size_t)2 * 4 * 65536 * 2);
constexpr size_t O_W5  = O_TV + AL((size_t)2 * 64 * 256 * UK * 2);
constexpr size_t O_QK  = O_W5 + AL((size_t)2 * 64 * 128 * 256 * 2 + 128 * 256 * 2);
constexpr size_t O_VW  = O_QK + AL((size_t)8 * M1 * 2);
constexpr size_t O_LAM = O_VW + AL((size_t)8 * M1 * 2);
constexpr size_t O_H   = O_LAM + AL((size_t)2 * 64 * 64 * 4 * 4);
constexpr size_t O_Z   = O_H + AL((size_t)TT * D * 2);
constexpr size_t O_F   = O_Z + AL((size_t)TT * D * 2);
constexpr size_t O_ACT = O_F + AL((size_t)TT * D * 4);
constexpr size_t WS_END = O_ACT + AL((size_t)TT * DFF * 2);
constexpr size_t O_U   = O_ACT;
constexpr size_t O_S   = O_U + AL((size_t)64 * USTRIDE * 2 + 256 * UK * 2);
static_assert(O_S + (size_t)64 * CR * 128 * 4 <= WS_END, "U/S alias overflow");
constexpr size_t O_WKT = O_ACT;
constexpr size_t O_WQP = O_WKT + (size_t)8 * M1 * 2;
constexpr size_t O_AMEM = O_WQP + (size_t)4 * M1 * 2;
constexpr size_t O_KBF = O_AMEM + (size_t)4 * 512 * 1024 * 2;
static_assert(O_KBF + (size_t)8 * 512 * 1024 * 2 <= WS_END, "prep alias overflow");

constexpr long OO_MEMK = (long)TT * D;
constexpr long OO_SRP = OO_MEMK + 2 * 2097152L;
constexpr long OO_SIP = OO_SRP + 16384;
constexpr long OO_PP = OO_SIP + 16384;
constexpr long OO_SRS = OO_PP + 61440;
constexpr long OO_SIS = OO_SRS + 65536;
constexpr long OO_PS = OO_SIS + 65536;
constexpr long OUT_TOTAL = OO_PS + 245760;

struct TJob { const float* src; bf16_t* dst; long sbs, dbs; int lds, ldd, tr, tc, mode, nb, tile0, pad; };
constexpr int NJOBS = 14;
struct Params {
    const float* in[32];
    float* out;
    unsigned char* ws;
    TJob jobs[NJOBS];
    int ntiles, pad;
};

__device__ __forceinline__ unsigned char* opq_ptr(unsigned char* x) {
    unsigned lo = (unsigned)(unsigned long long)x, hi = (unsigned)((unsigned long long)x >> 32);
    asm volatile("" : "+v"(lo), "+v"(hi));
    lo = __builtin_amdgcn_readfirstlane(lo); hi = __builtin_amdgcn_readfirstlane(hi);
    return (unsigned char*)(((unsigned long long)hi << 32) | lo); }
__device__ __forceinline__ int opaque_tid() { int t = threadIdx.x; asm volatile("" : "+v"(t)); return t; }
__device__ __forceinline__ unsigned cvt_pk_bf16(float lo, float hi) { unsigned r; asm volatile("v_cvt_pk_bf16_f32 %0, %1, %2" : "=v"(r) : "v"(lo), "v"(hi)); return r; }
__device__ __forceinline__ float bf2f(unsigned short b) { return __uint_as_float(((unsigned)b) << 16); }
__device__ __forceinline__ float shx(float v, int mask, int lane) { return __int_as_float(__builtin_amdgcn_ds_bpermute((lane ^ mask) << 2, __float_as_int(v))); }
__device__ __forceinline__ float wave_sum(float v, int lane) {
#pragma unroll
    for (int o = 1; o < 64; o <<= 1) v += shx(v, o, lane);
    return v;
}
__device__ __forceinline__ float wave_max(float v, int lane) {
#pragma unroll
    for (int o = 1; o < 64; o <<= 1) v = fmaxf(v, shx(v, o, lane));
    return v;
}
__device__ __forceinline__ float fsigmoid(float x) { return __builtin_amdgcn_rcpf(1.0f + __expf(-x)); }
__device__ __forceinline__ float gelu_tanh(float y) {
    const float t = 0.7978845608028654f * (y + 0.044715f * y * y * y);
    return y * fsigmoid(2.0f * t);
}

constexpr int BM = 256, BK = 64, HALF = 128, HTB = HALF * BK * 2, STAGE_BYTES = 8 * HTB;
constexpr int LDS_X = STAGE_BYTES;
constexpr int LDS_BYTES = STAGE_BYTES + 8192;
__device__ __forceinline__ int lds_byte(int r, int c) { const int st = (r >> 4) * 2 + (c >> 5), rr = r & 15, cc = c & 31, ob = rr * 64 + cc * 2; return st * 1024 + (ob ^ (((ob >> 9) & 1) << 5)); }
__device__ __forceinline__ void stage_rc(int b, int& R, int& C) { const int st = b / 1024, sb = b % 1024, swz = sb ^ (((sb >> 9) & 1) << 5); R = (st >> 1) * 16 + swz / 64; C = (st & 1) * 32 + (swz % 64) / 2; }
__device__ __forceinline__ int perm32(int rho) { const int n = rho >> 4, i = rho & 15; return 8 * (i >> 2) + 4 * n + (i & 3); }

struct Unit { const char* a; const char* b; long c; int i0, i1, i2, i3; };
struct GD {
    const bf16_t* A; const bf16_t* B; int lda, ldb, nt, n, d0, d1, d2; int sa[4], sb[4], sc[4];
    __device__ __forceinline__ bool unit(long L, Unit& u) const {
        if (L >= n) return false;
        int l = (int)L; const int i0 = l % d0; l /= d0; const int i1 = l % d1; l /= d1; const int i2 = l % d2; const int i3 = l / d2;
        u.i0 = i0; u.i1 = i1; u.i2 = i2; u.i3 = i3;
        u.a = (const char*)(A + (long)(i0 * sa[0] + i1 * sa[1] + i2 * sa[2] + i3 * sa[3]));
        u.b = (const char*)(B + (long)(i0 * sb[0] + i1 * sb[1] + i2 * sb[2] + i3 * sb[3]));
        u.c = (long)(i0 * sc[0] + i1 * sc[1] + i2 * sc[2] + i3 * sc[3]);
        return true;
    }
};
__device__ __forceinline__ GD gd_zero() { GD g; g.A = nullptr; g.B = nullptr; g.lda = g.ldb = 0; g.nt = 0; g.n = 0; g.d0 = g.d1 = g.d2 = 1;
    for (int i = 0; i < 4; ++i) { g.sa[i] = 0; g.sb[i] = 0; g.sc[i] = 0; } return g; }
__device__ __forceinline__ GD gd_plain(const bf16_t* A, int lda, const bf16_t* B, int ldb, int K, int nM, int nN, int ldc, int ctile) {
    GD g = gd_zero(); g.A = A; g.B = B; g.lda = lda; g.ldb = ldb; g.nt = K / BK; g.n = nM * nN; g.d0 = nM; g.d1 = nN; g.d2 = 1;
    g.sa[0] = 256 * lda; g.sb[1] = 256 * ldb; g.sc[0] = 256 * ldc; g.sc[1] = ctile; return g; }

typedef f32x4 Acc[2][2][4][2];

struct EpiF32 {
    static constexpr bool PERM = false;
    float* C; int ldc; const float* bias; const float* scale;
    __device__ __forceinline__ void operator()(const Acc& acc, const Unit& u, int wr, int wc, int fr, int fq) const {
        const int cb = (int)(u.c % ldc);
        const int row0 = wr * 64 + fr, col0 = wc * 32 + 4 * fq;
        f32x4 bv[2][2], sv[2][2];
#pragma unroll
        for (int bj = 0; bj < 2; ++bj)
#pragma unroll
            for (int n = 0; n < 2; ++n) {
                bv[bj][n] = bias ? *(const f32x4*)(bias + cb + col0 + bj * HALF + n * 16) : (f32x4){0.f, 0.f, 0.f, 0.f};
                sv[bj][n] = scale ? *(const f32x4*)(scale + cb + col0 + bj * HALF + n * 16) : (f32x4){1.f, 1.f, 1.f, 1.f}; }
#pragma unroll
        for (int ai = 0; ai < 2; ++ai)
#pragma unroll
            for (int m = 0; m < 4; ++m) { float* rowp = C + u.c + (long)(row0 + ai * HALF + m * 16) * ldc + col0;
#pragma unroll
                for (int bj = 0; bj < 2; ++bj)
#pragma unroll
                    for (int n = 0; n < 2; ++n) *(f32x4*)(rowp + bj * HALF + n * 16) = (acc[ai][bj][m][n] + bv[bj][n]) * sv[bj][n]; }
    }
};
struct EpiF32Bf16 {
    static constexpr bool PERM = false;
    float* C; bf16_t* O; int ldc;
    __device__ __forceinline__ void operator()(const Acc& acc, const Unit& u, int wr, int wc, int fr, int fq) const {
        const int row0 = wr * 64 + fr, col0 = wc * 32 + 4 * fq;
#pragma unroll
        for (int ai = 0; ai < 2; ++ai)
#pragma unroll
            for (int m = 0; m < 4; ++m) { const long off = u.c + (long)(row0 + ai * HALF + m * 16) * ldc + col0;
#pragma unroll
                for (int bj = 0; bj < 2; ++bj)
#pragma unroll
                    for (int n = 0; n < 2; ++n) { const f32x4 v = acc[ai][bj][m][n]; *(f32x4*)(C + off + bj * HALF + n * 16) = v;
                        u32x2 w; w.x = cvt_pk_bf16(v[0], v[1]); w.y = cvt_pk_bf16(v[2], v[3]); *(u32x2*)(O + off + bj * HALF + n * 16) = w; } }
    }
};
struct EpiBf16 {
    static constexpr bool PERM = true;
    bf16_t* O; int ldc; float s;
    __device__ __forceinline__ void operator()(const Acc& acc, const Unit& u, int wr, int wc, int fr, int fq) const {
        const int row0 = wr * 64 + fr, col0 = wc * 32 + 8 * fq;
#pragma unroll
        for (int ai = 0; ai < 2; ++ai)
#pragma unroll
            for (int m = 0; m < 4; ++m) { bf16_t* rowp = O + u.c + (long)(row0 + ai * HALF + m * 16) * ldc + col0;
#pragma unroll
                for (int bj = 0; bj < 2; ++bj) { const f32x4 v0 = acc[ai][bj][m][0] * s, v1 = acc[ai][bj][m][1] * s;
                    u32x4 w; w.x = cvt_pk_bf16(v0[0], v0[1]); w.y = cvt_pk_bf16(v0[2], v0[3]); w.z = cvt_pk_bf16(v1[0], v1[1]); w.w = cvt_pk_bf16(v1[2], v1[3]);
                    *(u32x4*)(rowp + bj * HALF) = w; } }
    }
};
struct EpiSwiGLU {
    static constexpr bool PERM = true;
    bf16_t* O; int ldc;
    __device__ __forceinline__ void operator()(const Acc& acc, const Unit& u, int wr, int wc, int fr, int fq) const {
        const int row0 = wr * 64 + fr, col0 = wc * 32 + 8 * fq;
#pragma unroll
        for (int ai = 0; ai < 2; ++ai)
#pragma unroll
            for (int m = 0; m < 4; ++m) { bf16_t* rowp = O + u.c + (long)(row0 + ai * HALF + m * 16) * ldc + col0;
                float r[8];
#pragma unroll
                for (int n = 0; n < 2; ++n)
#pragma unroll
                    for (int j = 0; j < 4; ++j) { const float g = acc[ai][0][m][n][j], up = acc[ai][1][m][n][j]; r[n * 4 + j] = g * fsigmoid(g) * up; }
                u32x4 w; w.x = cvt_pk_bf16(r[0], r[1]); w.y = cvt_pk_bf16(r[2], r[3]); w.z = cvt_pk_bf16(r[4], r[5]); w.w = cvt_pk_bf16(r[6], r[7]);
                *(u32x4*)rowp = w; }
    }
};
struct EpiGLU {
    static constexpr bool PERM = false;
    float* C; int ldc;
    __device__ __forceinline__ void operator()(const Acc& acc, const Unit& u, int wr, int wc, int fr, int fq) const {
        const int row0 = wr * 64 + fr, col0 = wc * 32 + 4 * fq;
#pragma unroll
        for (int ai = 0; ai < 2; ++ai)
#pragma unroll
            for (int m = 0; m < 4; ++m) { float* rowp = C + u.c + (long)(row0 + ai * HALF + m * 16) * ldc + col0;
#pragma unroll
                for (int n = 0; n < 2; ++n) { f32x4 o;
#pragma unroll
                    for (int j = 0; j < 4; ++j) o[j] = acc[ai][0][m][n][j] * fsigmoid(acc[ai][1][m][n][j]);
                    *(f32x4*)(rowp + n * 16) = o; } }
    }
};
struct EpiS5U {
    static constexpr bool PERM = true;
    bf16_t* Ub;
    __device__ __forceinline__ void operator()(const Acc& acc, const Unit& u, int wr, int wc, int fr, int fq) const {
#pragma unroll
        for (int ai = 0; ai < 2; ++ai)
#pragma unroll
            for (int m = 0; m < 4; ++m) { const int tok = u.i0 * 256 + ai * HALF + wr * 64 + m * 16 + fr;
#pragma unroll
                for (int bj = 0; bj < 2; ++bj) { const int g = u.i1 * 16 + 8 * bj + 2 * wc + (fq >> 1);
                    bf16_t* dst = Ub + (long)g * USTRIDE + (long)(tok >> 4) * UK + (tok & 15) * 16 + (fq & 1) * 8;
                    const f32x4 v0 = acc[ai][bj][m][0], v1 = acc[ai][bj][m][1];
                    u32x4 w; w.x = cvt_pk_bf16(v0[0], v0[1]); w.y = cvt_pk_bf16(v0[2], v0[3]); w.z = cvt_pk_bf16(v1[0], v1[1]); w.w = cvt_pk_bf16(v1[2], v1[3]);
                    *(u32x4*)dst = w; } }
    }
};
struct EpiS5S {
    static constexpr bool PERM = false;
    float* Sb;
    __device__ __forceinline__ void operator()(const Acc& acc, const Unit& u, int wr, int wc, int fr, int fq) const {
#pragma unroll
        for (int ai = 0; ai < 2; ++ai)
#pragma unroll
            for (int m = 0; m < 4; ++m) { const int row = u.i0 * 256 + ai * HALF + wr * 64 + m * 16 + fr;
                if (row < CR) { float* rowp = Sb + ((long)u.i1 * CR + row) * 128 + wc * 32 + 4 * fq;
#pragma unroll
                    for (int n = 0; n < 2; ++n) *(f32x4*)(rowp + n * 16) = acc[ai][0][m][n]; } }
    }
};
struct EpiS5D {
    static constexpr bool PERM = true;
    const bf16_t* Ub; const float* dvec; bf16_t* Zb;
    __device__ __forceinline__ void operator()(const Acc& acc, const Unit& u, int wr, int wc, int fr, int fq) const {
        const int g = u.i1, c0 = (fq & 1) * 8;
        const f32x4 d0 = *(const f32x4*)(dvec + g * 16 + c0), d1 = *(const f32x4*)(dvec + g * 16 + c0 + 4);
#pragma unroll
        for (int ai = 0; ai < 2; ++ai)
#pragma unroll
            for (int m = 0; m < 4; ++m) { const int row = u.i0 * 256 + ai * HALF + wr * 64 + m * 16 + fr;
                if (row < CR) {
#pragma unroll
                    for (int bj = 0; bj < 2; ++bj) { const int jt = 8 * bj + 2 * wc + (fq >> 1);
                        const u32x4 uu = *(const u32x4*)(Ub + (long)g * USTRIDE + (long)row * UK + jt * 16 + c0);
                        float y[8];
#pragma unroll
                        for (int q = 0; q < 4; ++q) { const unsigned w = uu[q]; const float ulo = __uint_as_float(w << 16), uhi = __uint_as_float(w & 0xffff0000u);
                            const float dl = (q < 2) ? d0[2 * q] : d1[2 * q - 4], dh = (q < 2) ? d0[2 * q + 1] : d1[2 * q - 3];
                            const float al = (q < 2) ? acc[ai][bj][m][0][2 * q] : acc[ai][bj][m][1][2 * q - 4], ah = (q < 2) ? acc[ai][bj][m][0][2 * q + 1] : acc[ai][bj][m][1][2 * q - 3];
                            y[2 * q] = gelu_tanh(al + dl * ulo); y[2 * q + 1] = gelu_tanh(ah + dh * uhi); }
                        u32x4 w; w.x = cvt_pk_bf16(y[0], y[1]); w.y = cvt_pk_bf16(y[2], y[3]); w.z = cvt_pk_bf16(y[4], y[5]); w.w = cvt_pk_bf16(y[6], y[7]);
                        *(u32x4*)(Zb + (long)(row * 16 + jt) * D + g * 16 + c0) = w; } } }
    }
};
struct EpiSoftmax {
    static constexpr bool PERM = true;
    bf16_t* O; int ldc; LAS float* Xl;
    __device__ __forceinline__ void operator()(const Acc& acc, const Unit& u, int wr, int wc, int fr, int fq) const {
        float mx[2][4]; const int ln = fr + 16 * fq;
#pragma unroll
        for (int ai = 0; ai < 2; ++ai)
#pragma unroll
            for (int m = 0; m < 4; ++m) { float a = -3.0e38f;
#pragma unroll
                for (int bj = 0; bj < 2; ++bj)
#pragma unroll
                    for (int n = 0; n < 2; ++n)
#pragma unroll
                        for (int j = 0; j < 4; ++j) a = fmaxf(a, acc[ai][bj][m][n][j]);
                a = fmaxf(a, shx(a, 16, ln)); a = fmaxf(a, shx(a, 32, ln));
                float s = 0.f;
#pragma unroll
                for (int bj = 0; bj < 2; ++bj)
#pragma unroll
                    for (int n = 0; n < 2; ++n)
#pragma unroll
                        for (int j = 0; j < 4; ++j) s += __expf(acc[ai][bj][m][n][j] - a);
                s += shx(s, 16, ln); s += shx(s, 32, ln);
                mx[ai][m] = a;
                const int r = ai * HALF + wr * 64 + m * 16 + fr;
                if (fq == 0) { Xl[(r * 4 + wc) * 2] = a; Xl[(r * 4 + wc) * 2 + 1] = s; } }
        asm volatile("s_waitcnt lgkmcnt(0)" ::: "memory"); __builtin_amdgcn_s_barrier(); asm volatile("" ::: "memory");
#pragma unroll
        for (int ai = 0; ai < 2; ++ai)
#pragma unroll
            for (int m = 0; m < 4; ++m) { const int r = ai * HALF + wr * 64 + m * 16 + fr;
                const f32x4 p0 = *(const LAS f32x4*)(Xl + r * 8), p1 = *(const LAS f32x4*)(Xl + r * 8 + 4);
                const float M = fmaxf(fmaxf(p0[0], p0[2]), fmaxf(p1[0], p1[2]));
                const float Ls = p0[1] * __expf(p0[0] - M) + p0[3] * __expf(p0[2] - M) + p1[1] * __expf(p1[0] - M) + p1[3] * __expf(p1[2] - M);
                const float inv = __builtin_amdgcn_rcpf(Ls);
                bf16_t* rowp = O + u.c + (long)r * ldc + wc * 32 + 8 * fq;
#pragma unroll
                for (int bj = 0; bj < 2; ++bj) { float e[8];
#pragma unroll
                    for (int n = 0; n < 2; ++n)
#pragma unroll
                        for (int j = 0; j < 4; ++j) e[n * 4 + j] = __expf(acc[ai][bj][m][n][j] - M) * inv;
                    u32x4 w; w.x = cvt_pk_bf16(e[0], e[1]); w.y = cvt_pk_bf16(e[2], e[3]); w.z = cvt_pk_bf16(e[4], e[5]); w.w = cvt_pk_bf16(e[6], e[7]);
                    *(u32x4*)(rowp + bj * HALF) = w; } }
        (void)mx;
    }
};

template <class Epi>
__device__ __forceinline__ void gemm_run(LAS unsigned char* lds, const GD g, const Epi& E, int rot) {
    const int tid = opaque_tid(), wid = __builtin_amdgcn_readfirstlane(tid >> 6), lane = tid & 63, wr = wid >> 2, wc = wid & 3, fr = lane & 15, fq = lane >> 4;
    const int nt = g.nt, G = gridDim.x;
    int cblk = blockIdx.x; asm volatile("" : "+s"(cblk)); cblk += rot; if (cblk >= G) cblk -= G;
    unsigned voffA[2], voffB[2];
#pragma unroll
    for (int i = 0; i < 2; ++i) { int R, C; stage_rc(tid * 16 + i * 8192, R, C); const int Rb = Epi::PERM ? ((R & ~31) + perm32(R & 31)) : R;
        voffA[i] = (unsigned)(R * g.lda + C) * 2u; voffB[i] = (unsigned)(Rb * g.ldb + C) * 2u; }
    const size_t kstep = (size_t)(BK * 2);
    const size_t hstepA = (size_t)HALF * g.lda * 2, hstepB = (size_t)HALF * g.ldb * 2;
    const unsigned ldsw = (unsigned)wid * 1024u;
    const int aoff = lds_byte(wr * 64 + fr, fq * 8), boff = lds_byte(wc * 32 + fr, fq * 8);
#define PG8_SA(b, h) (((b) * 2 + (h)) * HTB)
#define PG8_SB(b, h) ((4 + (b) * 2 + (h)) * HTB)
#define PG8_STAGE(bufoff, gbase, voff) do { _Pragma("unroll") for (int _i = 0; _i < 2; ++_i) \
        __builtin_amdgcn_global_load_lds((const unsigned*)((const char*)(gbase) + (voff)[_i]), (LAS unsigned*)(lds + (bufoff) + ldsw + _i * 8192), 16, 0, 0); } while (0)
#define PG8_LDA(dst, b, h) do { _Pragma("unroll") for (int m = 0; m < 4; ++m) _Pragma("unroll") for (int k = 0; k < 2; ++k) dst[m][k] = *(const LAS bf16x8*)(lds + PG8_SA(b, h) + aoff + m * 2048 + k * 1024); } while (0)
#define PG8_LDB(dst, b, h) do { _Pragma("unroll") for (int n = 0; n < 2; ++n) _Pragma("unroll") for (int k = 0; k < 2; ++k) dst[n][k] = *(const LAS bf16x8*)(lds + PG8_SB(b, h) + boff + n * 2048 + k * 1024); } while (0)
#define PG8_MMA(ai, bj, At, Bt) do { __builtin_amdgcn_s_setprio(1); _Pragma("unroll") for (int m = 0; m < 4; ++m) _Pragma("unroll") for (int n = 0; n < 2; ++n) _Pragma("unroll") for (int k = 0; k < 2; ++k) \
        acc[ai][bj][m][n] = __builtin_amdgcn_mfma_f32_16x16x32_bf16(Bt[n][k], At[m][k], acc[ai][bj][m][n], 0, 0, 0); __builtin_amdgcn_s_setprio(0); } while (0)
#define PG8_WAIT_V(n) asm volatile("s_waitcnt vmcnt(" #n ")" ::: "memory")
#define PG8_WAIT_L(n) asm volatile("s_waitcnt lgkmcnt(" #n ")" ::: "memory")
#define PG8_BAR __builtin_amdgcn_s_barrier()
#define PG8_SCHED __builtin_amdgcn_sched_barrier(0)
    Unit cur, nxt; int ui = 0;
    if (!g.unit(cblk, cur)) return;
    Acc acc;
#pragma unroll
    for (int a = 0; a < 2; ++a)
#pragma unroll
        for (int b = 0; b < 2; ++b)
#pragma unroll
            for (int m = 0; m < 4; ++m)
#pragma unroll
                for (int n = 0; n < 2; ++n) acc[a][b][m][n] = (f32x4){0.f, 0.f, 0.f, 0.f};
    bf16x8 At[4][2], B0[2][2], B1[2][2];
    const char* cA = cur.a; const char* cB = cur.b;
    PG8_STAGE(PG8_SB(0, 0), cB, voffB); PG8_STAGE(PG8_SA(0, 0), cA, voffA); PG8_STAGE(PG8_SB(0, 1), cB + hstepB, voffB); PG8_STAGE(PG8_SA(0, 1), cA + hstepA, voffA);
    if (wr == 1) PG8_BAR;
    PG8_WAIT_V(4); PG8_BAR;
    PG8_STAGE(PG8_SB(1, 0), cB + kstep, voffB); PG8_STAGE(PG8_SA(1, 0), cA + kstep, voffA); PG8_STAGE(PG8_SB(1, 1), cB + hstepB + kstep, voffB);
    PG8_WAIT_V(6); PG8_BAR;
    for (;;) {
        const bool has_next = g.unit((long)(ui + 1) * G + cblk, nxt);
        const char* nA = has_next ? nxt.a : cA; const char* nB = has_next ? nxt.b : cB;
        for (int t = 0; t < nt; t += 2) {
            const bool last = (t == nt - 2);
            const char* a1 = cA + (size_t)(t + 1) * kstep;
            const char* a2 = last ? nA : cA + (size_t)(t + 2) * kstep; const char* b2 = last ? nB : cB + (size_t)(t + 2) * kstep;
            const char* a3 = a2 + kstep; const char* b3 = b2 + kstep;
            PG8_LDB(B0, 0, 0); PG8_SCHED; PG8_LDA(At, 0, 0); PG8_STAGE(PG8_SA(1, 1), a1 + hstepA, voffA);
            PG8_WAIT_L(8); PG8_BAR; PG8_WAIT_L(0); PG8_MMA(0, 0, At, B0); PG8_BAR; PG8_SCHED;
            PG8_LDB(B1, 0, 1); PG8_STAGE(PG8_SB(0, 0), b2, voffB);
            PG8_BAR; PG8_WAIT_L(0); PG8_MMA(0, 1, At, B1); PG8_BAR;
            PG8_LDA(At, 0, 1); PG8_STAGE(PG8_SA(0, 0), a2, voffA);
            PG8_BAR; PG8_WAIT_L(0); PG8_MMA(1, 0, At, B0); PG8_BAR; PG8_SCHED;
            PG8_STAGE(PG8_SB(0, 1), b2 + hstepB, voffB);
            PG8_WAIT_V(6); PG8_BAR; PG8_MMA(1, 1, At, B1); PG8_BAR;
            PG8_LDB(B0, 1, 0); PG8_SCHED; PG8_LDA(At, 1, 0); PG8_STAGE(PG8_SA(0, 1), a2 + hstepA, voffA);
            PG8_WAIT_L(8); PG8_BAR; PG8_WAIT_L(0); PG8_MMA(0, 0, At, B0); PG8_BAR; PG8_SCHED;
            PG8_LDB(B1, 1, 1); PG8_STAGE(PG8_SB(1, 0), b3, voffB);
            PG8_BAR; PG8_WAIT_L(0); PG8_MMA(0, 1, At, B1); PG8_BAR;
            PG8_LDA(At, 1, 1); PG8_STAGE(PG8_SA(1, 0), a3, voffA);
            PG8_BAR; PG8_WAIT_L(0); PG8_MMA(1, 0, At, B0); PG8_BAR; PG8_SCHED;
            PG8_STAGE(PG8_SB(1, 1), b3 + hstepB, voffB);
            PG8_WAIT_V(6); PG8_BAR; PG8_MMA(1, 1, At, B1); PG8_BAR;
        }
        E(acc, cur, wr, wc, fr, fq);
        if (!has_next) break;
#pragma unroll
        for (int a = 0; a < 2; ++a)
#pragma unroll
            for (int b = 0; b < 2; ++b)
#pragma unroll
                for (int m = 0; m < 4; ++m)
#pragma unroll
                    for (int n = 0; n < 2; ++n) acc[a][b][m][n] = (f32x4){0.f, 0.f, 0.f, 0.f};
        cur = nxt; cA = nA; cB = nB; ++ui;
    }
    PG8_WAIT_V(0);
    if (wr == 0) PG8_BAR;
    PG8_BAR;
#undef PG8_SA
#undef PG8_SB
#undef PG8_STAGE
#undef PG8_LDA
#undef PG8_LDB
#undef PG8_MMA
#undef PG8_WAIT_V
#undef PG8_WAIT_L
#undef PG8_BAR
#undef PG8_SCHED
}


struct SkF32 { float* C; int ldc; const float* bias; const float* scale;
    __device__ __forceinline__ void operator()(int row, int col, const float (&v)[2][2]) const {
#pragma unroll
        for (int q = 0; q < 2; ++q) { const float b = bias ? bias[col + q] : 0.f, sc = scale ? scale[col + q] : 1.f; C[(long)row * ldc + col + q] = (v[0][q] + b) * sc; } } };
struct SkBf16 { bf16_t* O; int ldc;
    __device__ __forceinline__ void operator()(int row, int col, const float (&v)[2][2]) const { *(unsigned*)(O + (long)row * ldc + col) = cvt_pk_bf16(v[0][0], v[0][1]); } };
struct SkSwiGLU { bf16_t* O; int ldc;
    __device__ __forceinline__ void operator()(int row, int col, const float (&v)[2][2]) const {
        *(unsigned*)(O + (long)row * ldc + col) = cvt_pk_bf16(v[0][0] * fsigmoid(v[0][0]) * v[1][0], v[0][1] * fsigmoid(v[0][1]) * v[1][1]); } };
struct SkGLU { float* C; int ldc;
    __device__ __forceinline__ void operator()(int row, int col, const float (&v)[2][2]) const {
        C[(long)row * ldc + col] = v[0][0] * fsigmoid(v[1][0]); C[(long)row * ldc + col + 1] = v[0][1] * fsigmoid(v[1][1]); } };
struct SkS5U { bf16_t* Ub;
    __device__ __forceinline__ void operator()(int row, int col, const float (&v)[2][2]) const { const int tok = TP + row, g = col >> 4;
        *(unsigned*)(Ub + (long)g * USTRIDE + (long)(tok >> 4) * UK + (tok & 15) * 16 + (col & 15)) = cvt_pk_bf16(v[0][0], v[0][1]); } };

template <int NT, class Epi>
__device__ __forceinline__ void skinny(unsigned char* shm, const bf16_t* A, int lda, const bf16_t* B, int ldb, int K, int ncg, bool pair, int agd, const Epi& E, int cu0, int ncu) {
    float* red = (float*)shm;
    const int tid = opaque_tid(), wid = tid >> 6, lane = tid & 63, fr = lane & 15, fq = lane >> 4;
    int cblk = blockIdx.x; asm volatile("" : "+s"(cblk));
    cblk -= cu0; if (cblk < 0 || cblk >= ncu) return;
    const int kslice = K >> 3, steps = kslice >> 5, nitems = 4 * ncg;
    for (int item = cblk; item < nitems; item += ncu) {
        const int rb = item & 3, cgi = item >> 2;
        const int brow = pair ? ((cgi >> 3) * 256 + (cgi & 7) * 16) : cgi * 16;
        const bf16_t* ap = A + (long)(rb * 64 + fr) * lda + (cgi / agd) * 256 + wid * kslice + fq * 8;
        const bf16_t* bp = B + (long)(brow + fr) * ldb + wid * kslice + fq * 8;
        f32x4 acc[NT][4];
#pragma unroll
        for (int t = 0; t < NT; ++t)
#pragma unroll
            for (int m = 0; m < 4; ++m) acc[t][m] = (f32x4){0.f, 0.f, 0.f, 0.f};
#pragma unroll 4
        for (int st = 0; st < steps; ++st) {
            bf16x8 af[4], bfr[NT];
#pragma unroll
            for (int m = 0; m < 4; ++m) af[m] = *(const bf16x8*)(ap + (long)m * 16 * lda + st * 32);
#pragma unroll
            for (int t = 0; t < NT; ++t) bfr[t] = *(const bf16x8*)(bp + (long)t * 128 * ldb + st * 32);
#pragma unroll
            for (int t = 0; t < NT; ++t)
#pragma unroll
                for (int m = 0; m < 4; ++m) acc[t][m] = __builtin_amdgcn_mfma_f32_16x16x32_bf16(af[m], bfr[t], acc[t][m], 0, 0, 0);
        }
        __syncthreads();
#pragma unroll
        for (int t = 0; t < NT; ++t)
#pragma unroll
            for (int m = 0; m < 4; ++m)
#pragma unroll
                for (int jj = 0; jj < 4; ++jj) red[((wid * NT + t) * 4 + m) * 256 + (4 * fq + jj) * 16 + fr] = acc[t][m][jj];
        __syncthreads();
        { const int e = tid * 2, row = e >> 4, col = e & 15; float v[2][2];
#pragma unroll
          for (int t = 0; t < 2; ++t) { v[t][0] = 0.f; v[t][1] = 0.f;
              if (t < NT) {
#pragma unroll
                  for (int w = 0; w < 8; ++w) { const float* rp = red + ((w * NT + t) * 4 + (row >> 4)) * 256 + (row & 15) * 16 + col; v[t][0] += rp[0]; v[t][1] += rp[1]; } } }
          E(rb * 64 + row, cgi * 16 + col, v); }
    }
    __syncthreads();
}

__device__ __forceinline__ void rows_phase(const float* xsrc, const float* f, const float* gpost, float w, const float* gpre, float* xdst, bf16_t* h, int r0, int r1) {
    const int tid = opaque_tid(); const int lane = tid & 63, gw = blockIdx.x * 8 + (tid >> 6), nw = gridDim.x * 8;
    for (int r = r0 + gw; r < r1; r += nw) {
        f32x4 xv[4];
#pragma unroll
        for (int k = 0; k < 4; ++k) xv[k] = *(const f32x4*)(xsrc + (long)r * D + k * 256 + lane * 4);
        if (f) {
            f32x4 fv[4]; float ss = 0.f;
#pragma unroll
            for (int k = 0; k < 4; ++k) { fv[k] = *(const f32x4*)(f + (long)r * D + k * 256 + lane * 4); ss += fv[k][0] * fv[k][0] + fv[k][1] * fv[k][1] + fv[k][2] * fv[k][2] + fv[k][3] * fv[k][3]; }
            ss = wave_sum(ss, lane);
            const float rs = w * rsqrtf(ss * (1.0f / D) + EPS);
#pragma unroll
            for (int k = 0; k < 4; ++k) { const f32x4 gp = *(const f32x4*)(gpost + k * 256 + lane * 4); xv[k] = xv[k] + fv[k] * gp * rs; }
        }
        if (xdst) {
#pragma unroll
            for (int k = 0; k < 4; ++k) *(f32x4*)(xdst + (long)r * D + k * 256 + lane * 4) = xv[k];
        }
        if (h) {
            float ss = 0.f;
#pragma unroll
            for (int k = 0; k < 4; ++k) ss += xv[k][0] * xv[k][0] + xv[k][1] * xv[k][1] + xv[k][2] * xv[k][2] + xv[k][3] * xv[k][3];
            ss = wave_sum(ss, lane);
            const float rs = rsqrtf(ss * (1.0f / D) + EPS);
#pragma unroll
            for (int k = 0; k < 4; ++k) { const f32x4 gp = *(const f32x4*)(gpre + k * 256 + lane * 4); const f32x4 o = xv[k] * gp * rs;
                u32x2 wv; wv.x = cvt_pk_bf16(o[0], o[1]); wv.y = cvt_pk_bf16(o[2], o[3]); *(u32x2*)(h + (long)r * D + k * 256 + lane * 4) = wv; }
        }
    }
}

__device__ __forceinline__ void tconv_phase(const Params& p, unsigned char* shm) {
    bf16_t* tile = (bf16_t*)shm;
    const int tid = opaque_tid();
    for (int T = blockIdx.x; T < p.ntiles; T += gridDim.x) {
        int j = 0;
#pragma unroll 1
        for (int q = 1; q < NJOBS; ++q) if (T >= p.jobs[q].tile0) j = q;
        const TJob jb = p.jobs[j];
        int t = T - jb.tile0; const int per = jb.tr * jb.tc; const int b = t / per; t -= b * per; const int tr = t / jb.tc, tc = t % jb.tc;
        const float* src = jb.src + (long)b * jb.sbs; bf16_t* dst = jb.dst + (long)b * jb.dbs;
        const int R0 = tr * 64, C0 = tc * 64;
        { const int r = tid >> 3, c8 = (tid & 7) * 8;
          const f32x4 v0 = *(const f32x4*)(src + (long)(R0 + r) * jb.lds + C0 + c8), v1 = *(const f32x4*)(src + (long)(R0 + r) * jb.lds + C0 + c8 + 4);
          if (jb.mode == 3) { u32x4 w; w.x = cvt_pk_bf16(v0[0], v0[1]); w.y = cvt_pk_bf16(v0[2], v0[3]); w.z = cvt_pk_bf16(v1[0], v1[1]); w.w = cvt_pk_bf16(v1[2], v1[3]);
              *(u32x4*)(dst + (long)(R0 + r) * jb.ldd + C0 + c8) = w; continue; }
          const unsigned a0 = cvt_pk_bf16(v0[0], v0[1]), a1 = cvt_pk_bf16(v0[2], v0[3]), a2 = cvt_pk_bf16(v1[0], v1[1]), a3 = cvt_pk_bf16(v1[2], v1[3]);
          tile[(c8 + 0) * 72 + r] = (bf16_t)(a0 & 0xffff); tile[(c8 + 1) * 72 + r] = (bf16_t)(a0 >> 16);
          tile[(c8 + 2) * 72 + r] = (bf16_t)(a1 & 0xffff); tile[(c8 + 3) * 72 + r] = (bf16_t)(a1 >> 16);
          tile[(c8 + 4) * 72 + r] = (bf16_t)(a2 & 0xffff); tile[(c8 + 5) * 72 + r] = (bf16_t)(a2 >> 16);
          tile[(c8 + 6) * 72 + r] = (bf16_t)(a3 & 0xffff); tile[(c8 + 7) * 72 + r] = (bf16_t)(a3 >> 16); }
        __syncthreads();
        { const int c = tid >> 3, r8 = (tid & 7) * 8; const int cc = C0 + c;
          int drow = cc; if (jb.mode == 1) drow = (cc >> 7) * 256 + (cc & 127); else if (jb.mode == 2) drow = (cc >> 7) * 256 + 128 + (cc & 127);
          const u32x4 w = *(const u32x4*)(tile + c * 72 + r8);
          *(u32x4*)(dst + (long)drow * jb.ldd + R0 + r8) = w; }
        __syncthreads();
    }
}

__device__ __forceinline__ void lam_pow(const Params& p, int j, int g, int pp, int n, float& re, float& im) {
    const double dt = exp((double)p.in[26][j * 64 + g]);
    const long gp = ((long)j * 64 + g) * 64 + pp;
    const double lr = (double)p.in[19][gp] * dt * n, li = (double)p.in[20][gp] * dt * n;
    const double red = li - 6.283185307179586476925 * rint(li * 0.15915494309189533577);
    const float mg = (float)exp(lr); float sn, cs; sincosf((float)red, &sn, &cs); re = mg * cs; im = mg * sn;
}
__device__ __forceinline__ void s5prep_phase(const Params& p, unsigned char* shm) {
    float* lamr = (float*)shm;
    float* lami = lamr + 17 * 64;
    float* Bbr = lami + 17 * 64;
    float* Bbi = Bbr + 1024;
    float* Ccr = Bbi + 1024;
    float* Cci = Ccr + 1024;
    float* Kt = Cci + 1024;
    const int tid = opaque_tid();
    bf16_t* TV = (bf16_t*)(p.ws + O_TV); bf16_t* W5 = (bf16_t*)(p.ws + O_W5);
    for (int job = blockIdx.x; job < 128; job += gridDim.x) {
        const int j = job >> 6, g = job & 63;
        __syncthreads();
        if (tid < 64) {
            const int pp = tid; const long gp = ((long)j * 64 + g) * 64 + pp;
            const float dt = expf(p.in[26][j * 64 + g]);
            const float are = p.in[19][gp], aim = p.in[20][gp];
            const float lr = are * dt, li = aim * dt;
            for (int t = 0; t <= 16; ++t) { const float mg = expf(lr * t); float sn, cs; sincosf(li * t, &sn, &cs); lamr[t * 64 + pp] = mg * cs; lami[t * 64 + pp] = mg * sn; }
            const float nr = lamr[64 + pp] - 1.0f, ni = lami[64 + pp]; const float den = are * are + aim * aim;
            const float cr = (nr * are + ni * aim) / den, ci = (ni * are - nr * aim) / den;
            for (int c = 0; c < 16; ++c) { const float br = p.in[21][gp * 16 + c], bi = p.in[22][gp * 16 + c];
                Bbr[pp * 16 + c] = cr * br - ci * bi; Bbi[pp * 16 + c] = cr * bi + ci * br; }
            float q0, q1, q2, q3; lam_pow(p, j, g, pp, 16, q0, q1); lam_pow(p, j, g, pp, 1024, q2, q3);
            *(f32x4*)((float*)(p.ws + O_LAM) + gp * 4) = (f32x4){q0, q1, q2, q3};
        }
        for (int e = tid; e < 1024; e += 512) { const long gi = ((long)j * 64 + g) * 1024 + e; Ccr[e] = p.in[23][gi]; Cci[e] = p.in[24][gi]; }
        __syncthreads();
        for (int o = tid; o < 4096; o += 512) { const int tau = o >> 8, c = (o >> 4) & 15, cp = o & 15; float s = 0.f;
            for (int pp = 0; pp < 64; ++pp) { const float clr = Ccr[c * 64 + pp] * lamr[tau * 64 + pp] - Cci[c * 64 + pp] * lami[tau * 64 + pp];
                const float cli = Ccr[c * 64 + pp] * lami[tau * 64 + pp] + Cci[c * 64 + pp] * lamr[tau * 64 + pp];
                s += clr * Bbr[pp * 16 + cp] - cli * Bbi[pp * 16 + cp]; }
            Kt[o] = s; }
        __syncthreads();
        bf16_t* tv = TV + ((long)j * 64 + g) * 256 * UK;
        for (int e = tid; e < 256 * (UK / 2); e += 512) { const int n = e / (UK / 2), k = (e % (UK / 2)) * 2; const int jj = n >> 4, c = n & 15; float v[2];
#pragma unroll
            for (int q = 0; q < 2; ++q) { const int kk = k + q;
                if (kk < 256) { const int i = kk >> 4, cp = kk & 15; v[q] = (i <= jj) ? Kt[(jj - i) * 256 + c * 16 + cp] : 0.f; }
                else if (kk < 320) { const int pp = kk - 256; v[q] = Ccr[c * 64 + pp] * lamr[(jj + 1) * 64 + pp] - Cci[c * 64 + pp] * lami[(jj + 1) * 64 + pp]; }
                else { const int pp = kk - 320; v[q] = -(Ccr[c * 64 + pp] * lami[(jj + 1) * 64 + pp] + Cci[c * 64 + pp] * lamr[(jj + 1) * 64 + pp]); } }
            *(unsigned*)(tv + (long)n * UK + k) = cvt_pk_bf16(v[0], v[1]); }
        bf16_t* w5 = W5 + ((long)j * 64 + g) * 128 * 256;
        for (int e = tid; e < 128 * 128; e += 512) { const int n = e >> 7, k = (e & 127) * 2; const int pp = n & 63; const bool im = n >= 64; float v[2];
#pragma unroll
            for (int q = 0; q < 2; ++q) { const int kk = k + q, i = kk >> 4, cp = kk & 15; const int t = 15 - i;
                const float re = lamr[t * 64 + pp] * Bbr[pp * 16 + cp] - lami[t * 64 + pp] * Bbi[pp * 16 + cp];
                const float ii = lamr[t * 64 + pp] * Bbi[pp * 16 + cp] + lami[t * 64 + pp] * Bbr[pp * 16 + cp];
                v[q] = im ? ii : re; }
            *(unsigned*)(w5 + (long)n * 256 + k) = cvt_pk_bf16(v[0], v[1]); }
    }
    __syncthreads();
}

__device__ __forceinline__ void scan_phase(const Params& p, int j, unsigned char* shm) {
    float* E = (float*)shm;
    const int tid = opaque_tid();
    const float* S = (const float*)(p.ws + O_S); bf16_t* U = (bf16_t*)(p.ws + O_U);
    for (int item = blockIdx.x; item < 128; item += gridDim.x) {
        const int seq = item >> 6, g = item & 63, pp = tid & 63, sc = tid >> 6;
        const f32x4 lq = *(const f32x4*)((const float*)(p.ws + O_LAM) + (((long)j * 64 + g) * 64 + pp) * 4); const float ar = lq[0], ai = lq[1], br = lq[2], bi = lq[3];
        const int row0 = seq * 512 + sc * 64;
        const float* Sg = S + ((long)g * CR + row0) * 128 + pp;
        float er = 0.f, ei = 0.f;
#pragma unroll 8
        for (int k = 0; k < 64; ++k) { const float sr = Sg[k * 128], si = Sg[k * 128 + 64]; const float nr = ar * er - ai * ei + sr, ni = ar * ei + ai * er + si; er = nr; ei = ni; }
        __syncthreads();
        E[(sc * 64 + pp) * 2] = er; E[(sc * 64 + pp) * 2 + 1] = ei;
        __syncthreads();
        float hr = 0.f, hi = 0.f;
        for (int m = 0; m < sc; ++m) { const float xr = E[(m * 64 + pp) * 2], xi = E[(m * 64 + pp) * 2 + 1]; const float nr = br * hr - bi * hi + xr, ni = br * hi + bi * hr + xi; hr = nr; hi = ni; }
        bf16_t* Ug = U + (long)g * USTRIDE + (long)row0 * UK + 256 + pp;
#pragma unroll 8
        for (int k = 0; k < 64; ++k) { const float sr = Sg[k * 128], si = Sg[k * 128 + 64];
            Ug[k * UK] = (bf16_t)(cvt_pk_bf16(hr, 0.f) & 0xffff); Ug[k * UK + 64] = (bf16_t)(cvt_pk_bf16(hi, 0.f) & 0xffff);
            const float nr = ar * hr - ai * hi + sr, ni = ar * hi + ai * hr + si; hr = nr; hi = ni; }
        if (sc == 7) { const long o = (((long)j * 2 + seq) * 64 + g) * 64 + pp; p.out[OO_SRP + o] = hr; p.out[OO_SIP + o] = hi; }
    }
    { const int lane = tid & 63, gw = blockIdx.x * 8 + (tid >> 6), nw = gridDim.x * 8;
      for (int item = gw; item < 512; item += nw) { const int s = item >> 6, g = item & 63, pp = lane;
          const f32x4 lq = *(const f32x4*)((const float*)(p.ws + O_LAM) + (((long)j * 64 + g) * 64 + pp) * 4); const float ar = lq[0], ai = lq[1];
          const long si = (((long)j * 8 + s) * 64 + g) * 64 + pp;
          float hr = p.in[4][si], hi = p.in[5][si];
          const int row0 = 1024 + 2 * s;
          const float* Sg = S + ((long)g * CR + row0) * 128 + pp;
          bf16_t* Ug = U + (long)g * USTRIDE + (long)row0 * UK + 256 + pp;
#pragma unroll
          for (int k = 0; k < 2; ++k) { const float sr = Sg[k * 128], sim = Sg[k * 128 + 64];
              Ug[k * UK] = (bf16_t)(cvt_pk_bf16(hr, 0.f) & 0xffff); Ug[k * UK + 64] = (bf16_t)(cvt_pk_bf16(hi, 0.f) & 0xffff);
              const float nr = ar * hr - ai * hi + sr, ni = ar * hi + ai * hr + sim; hr = nr; hi = ni; }
          p.out[OO_SRS + si] = hr; p.out[OO_SIS + si] = hi; } }
}

__device__ __forceinline__ f32x4 pool_row(const float* F, const float* hist, int base, int t, int col) {
    if (t >= 0) return *(const f32x4*)(F + (long)(base + t) * D + col);
    if (hist) return *(const f32x4*)(hist + (long)(15 + t) * D + col);
    return (f32x4){0.f, 0.f, 0.f, 0.f};
}
__device__ __forceinline__ void pool_phase(const Params& p, int j) {
    const float* F = (const float*)(p.ws + O_F); bf16_t* Z = (bf16_t*)(p.ws + O_Z);
    const int tid = opaque_tid(); const int lane = tid & 63, gw = blockIdx.x * 8 + (tid >> 6), nw = gridDim.x * 8;
    for (int item = gw; item < 520 * 4; item += nw) {
        const int seg = item >> 2, grp = item & 3; const int W = 2 << grp; const int col = grp * 256 + lane * 4;
        const int tok0 = seg * 32;
        int base, t0, pos0; const float* hist = nullptr;
        if (tok0 < TP) { base = (tok0 >> 13) << 13; t0 = tok0 - base; pos0 = 0; }
        else { const int s = (tok0 - TP) >> 5; base = tok0; t0 = 0; pos0 = 1024; hist = p.in[6] + ((long)j * 8 + s) * 15 * D; }
        f32x4 sum = (f32x4){0.f, 0.f, 0.f, 0.f};
        for (int k = 1; k < W; ++k) sum = sum + pool_row(F, hist, base, t0 - k, col);
        for (int i = 0; i < 32; ++i) { const int t = t0 + i; const f32x4 u = *(const f32x4*)(F + (long)(base + t) * D + col);
            sum = sum + u;
            const int cnt = min(pos0 + t + 1, W); const float inv = 1.0f / (float)cnt;
            const f32x4 o = sum * inv - u;
            u32x2 wv; wv.x = cvt_pk_bf16(o[0], o[1]); wv.y = cvt_pk_bf16(o[2], o[3]); *(u32x2*)(Z + (long)(base + t) * D + col) = wv;
            sum = sum - pool_row(F, hist, base, t - W + 1, col); }
    }
    for (int e = blockIdx.x * 512 + tid; e < 10 * 15 * 256; e += gridDim.x * 512) {
        const int c4 = (e & 255) * 4, r = (e >> 8) % 15, sq = (e >> 8) / 15;
        if (sq < 2) { const f32x4 v = *(const f32x4*)(F + (long)(sq * 8192 + 8177 + r) * D + c4); *(f32x4*)(p.out + OO_PP + (((long)j * 2 + sq) * 15 + r) * D + c4) = v; }
        else { const int s = sq - 2; const f32x4 v = *(const f32x4*)(F + (long)(TP + s * 32 + 17 + r) * D + c4); *(f32x4*)(p.out + OO_PS + (((long)j * 8 + s) * 15 + r) * D + c4) = v; }
    }
}

__device__ __forceinline__ void sample_attn_phase(const Params& p, int l, unsigned char* shm) {
    float* Ssm = (float*)shm;
    const int tid = opaque_tid(), wid = tid >> 6, lane = tid & 63, fr = lane & 15, fq = lane >> 4;
    const bf16_t* Q = (const bf16_t*)(p.ws + O_Z) + (long)TP * D; bf16_t* Oo = (bf16_t*)(p.ws + O_H) + (long)TP * D;
    for (int item = blockIdx.x; item < 32; item += gridDim.x) {
        const int b = item >> 2, h = item & 3;
        const float* Kc = p.in[2] + (((long)l * 8 + b) * 256) * D + h * 256;
        const float* Vc = p.in[3] + (((long)l * 8 + b) * 256) * D + h * 256;
        f32x4 acc[2][2];
#pragma unroll
        for (int a = 0; a < 2; ++a)
#pragma unroll
            for (int n = 0; n < 2; ++n) acc[a][n] = (f32x4){0.f, 0.f, 0.f, 0.f};
        for (int st = 0; st < 8; ++st) {
            bf16x8 af[2], bfr[2];
#pragma unroll
            for (int a = 0; a < 2; ++a) af[a] = *(const bf16x8*)(Q + (long)(b * 32 + a * 16 + fr) * D + h * 256 + st * 32 + fq * 8);
#pragma unroll
            for (int n = 0; n < 2; ++n) { const float* kp = Kc + (long)(wid * 32 + n * 16 + fr) * D + st * 32 + fq * 8;
                const f32x4 k0 = *(const f32x4*)kp, k1 = *(const f32x4*)(kp + 4);
                u32x4 w; w.x = cvt_pk_bf16(k0[0], k0[1]); w.y = cvt_pk_bf16(k0[2], k0[3]); w.z = cvt_pk_bf16(k1[0], k1[1]); w.w = cvt_pk_bf16(k1[2], k1[3]);
                bfr[n] = __builtin_bit_cast(bf16x8, w); }
#pragma unroll
            for (int a = 0; a < 2; ++a)
#pragma unroll
                for (int n = 0; n < 2; ++n) acc[a][n] = __builtin_amdgcn_mfma_f32_16x16x32_bf16(af[a], bfr[n], acc[a][n], 0, 0, 0);
        }
        __syncthreads();
#pragma unroll
        for (int a = 0; a < 2; ++a)
#pragma unroll
            for (int n = 0; n < 2; ++n)
#pragma unroll
                for (int jj = 0; jj < 4; ++jj) Ssm[(a * 16 + 4 * fq + jj) * 256 + wid * 32 + n * 16 + fr] = acc[a][n][jj] * 0.0625f;
        __syncthreads();
        for (int rr = 0; rr < 4; ++rr) { const int r = wid * 4 + rr; f32x4 v = *(const f32x4*)(Ssm + r * 256 + lane * 4);
            const float mxv = wave_max(fmaxf(fmaxf(v[0], v[1]), fmaxf(v[2], v[3])), lane);
            v[0] = __expf(v[0] - mxv); v[1] = __expf(v[1] - mxv); v[2] = __expf(v[2] - mxv); v[3] = __expf(v[3] - mxv);
            const float inv = 1.0f / wave_sum(v[0] + v[1] + v[2] + v[3], lane);
            *(f32x4*)(Ssm + r * 256 + lane * 4) = v * inv; }
        __syncthreads();
        { const int d = tid & 255, qh = tid >> 8; float o[16];
#pragma unroll
          for (int q = 0; q < 16; ++q) o[q] = 0.f;
          for (int m = 0; m < 256; m += 4) { const float v0 = Vc[(long)m * D + d], v1 = Vc[(long)(m + 1) * D + d], v2 = Vc[(long)(m + 2) * D + d], v3 = Vc[(long)(m + 3) * D + d];
#pragma unroll
              for (int q = 0; q < 16; ++q) { const f32x4 pv = *(const f32x4*)(Ssm + (qh * 16 + q) * 256 + m); o[q] += pv[0] * v0 + pv[1] * v1 + pv[2] * v2 + pv[3] * v3; } }
#pragma unroll
          for (int q = 0; q < 16; ++q) Oo[(long)(b * 32 + qh * 16 + q) * D + h * 256 + d] = (bf16_t)(cvt_pk_bf16(o[q], 0.f) & 0xffff); }
        __syncthreads();
    }
}

__global__ void __launch_bounds__(512, 2) mega(const Params p) {
    extern __shared__ __attribute__((aligned(16))) unsigned char shm[];
    cg::grid_group grid = cg::this_grid();
    LAS unsigned char* lds = (LAS unsigned char*)shm;
#define ws (opq_ptr(p.ws))
#define X ((float*)opq_ptr((unsigned char*)p.out))
#define H ((bf16_t*)(ws + O_H))
#define Z ((bf16_t*)(ws + O_Z))
#define F ((float*)(ws + O_F))
#define ACT ((bf16_t*)(ws + O_ACT))
#define U ((bf16_t*)(ws + O_U))
#define S ((float*)(ws + O_S))
#define npre ((const float*)opq_ptr((unsigned char*)p.in[8]))
#define npost ((const float*)opq_ptr((unsigned char*)p.in[9]))

    tconv_phase(p, shm);
    s5prep_phase(p, shm);
#pragma unroll 1
    for (int l = 0; l < 4; ++l) rows_phase(p.in[7], nullptr, nullptr, 0.f, p.in[10] + l * D, nullptr, (bf16_t*)(ws + O_AMEM) + (long)l * 512 * D, 0, 512);
    rows_phase(p.in[0], nullptr, nullptr, 0.f, npre, X, H, 0, TP);
    rows_phase(p.in[1] - (long)TP * D, nullptr, nullptr, 0.f, npre, X, H, TP, TT);
    grid.sync();
    { GD g = gd_zero(); g.A = (const bf16_t*)(ws + O_AMEM); g.B = (const bf16_t*)(ws + O_WKT); g.lda = D; g.ldb = D; g.nt = 16; g.n = 64; g.d0 = 2; g.d1 = 4; g.d2 = 4;
      g.sa[0] = (int)(256L * D); g.sa[2] = (int)(512L * D); g.sb[1] = (int)(256L * D); g.sb[2] = (int)(M1); g.sb[3] = (int)(4 * M1);
      g.sc[0] = (int)(256L * D); g.sc[1] = (int)(256); g.sc[2] = (int)(512L * D); g.sc[3] = (int)(2097152L);
      EpiF32Bf16 e; e.C = p.out + OO_MEMK; e.O = (bf16_t*)(ws + O_KBF); e.ldc = D;
      gemm_run(lds, g, e, 0); }
    grid.sync();
    { GD g = gd_zero(); g.A = (const bf16_t*)(ws + O_KBF); g.B = (const bf16_t*)(ws + O_WQP); g.lda = D; g.ldb = D; g.nt = 4; g.n = 128; g.d0 = 4; g.d1 = 4; g.d2 = 2;
      g.sa[1] = (int)(256); g.sa[2] = (int)(256L * D); g.sa[3] = (int)(512L * D); g.sb[0] = (int)(256L * D); g.sb[1] = (int)(256); g.sb[3] = (int)(M1);
      g.sc[0] = (int)(256); g.sc[1] = (int)(256L * D); g.sc[2] = (int)(M1); g.sc[3] = (int)(2 * M1);
      EpiBf16 e; e.O = (bf16_t*)(ws + O_QK); e.ldc = D; e.s = 0.0625f;
      gemm_run(lds, g, e, 0); }
    { GD g = gd_zero(); g.A = (const bf16_t*)(ws + O_WOT); g.B = (const bf16_t*)(ws + O_KBF) + 2097152L; g.lda = D; g.ldb = D; g.nt = 4; g.n = 128; g.d0 = 4; g.d1 = 4; g.d2 = 2;
      g.sa[0] = (int)(256L * D); g.sa[1] = (int)(256); g.sa[3] = (int)(M1); g.sb[1] = (int)(256); g.sb[2] = (int)(256L * D); g.sb[3] = (int)(512L * D);
      g.sc[0] = (int)(256L * D); g.sc[1] = (int)(256); g.sc[2] = (int)(M1); g.sc[3] = (int)(2 * M1);
      EpiBf16 e; e.O = (bf16_t*)(ws + O_VW); e.ldc = D; e.s = 1.0f;
      gemm_run(lds, g, e, 128); }
    grid.sync();

#pragma unroll 1
    for (int l = 0; l < 4; ++l) {
        const int j = l >> 1;
#pragma unroll 1
        for (int sub = 0; sub < 4; ++sub) {
            if (sub == 0 || sub == 3) {
                const int s = sub ? 1 : 0;
                { GD g = gd_plain(H, D, (const bf16_t*)(ws + O_WGU) + (long)(l * 2 + s) * 5632 * D, D, D, 64, 22, DFF, 128);
                  EpiSwiGLU e; e.O = ACT; e.ldc = DFF; gemm_run(lds, g, e, 0); }
                { SkSwiGLU e; e.O = ACT + (long)TP * DFF; e.ldc = DFF;
                  skinny<2>(shm, H + (long)TP * D, D, (const bf16_t*)(ws + O_WGU) + (long)(l * 2 + s) * 5632 * D, D, D, 176, true, 1 << 20, e, 128, 128); }
                grid.sync();
                { SkF32 e; e.C = F + (long)TP * D; e.ldc = D; e.bias = nullptr; e.scale = nullptr;
                  skinny<1>(shm, ACT + (long)TP * DFF, DFF, (const bf16_t*)(ws + O_WDN) + (long)(l * 2 + s) * D * DFF, DFF, DFF, 64, false, 1 << 20, e, 0, 256); }
                { GD g = gd_plain(ACT, DFF, (const bf16_t*)(ws + O_WDN) + (long)(l * 2 + s) * D * DFF, DFF, DFF, 64, 4, D, 256);
                  EpiF32 e; e.C = F; e.ldc = D; e.bias = nullptr; e.scale = nullptr; gemm_run(lds, g, e, 0); }
                grid.sync();
                const bool lastsub = (l == 3 && sub == 3);
                rows_phase(X, F, npost + (l * 4 + sub) * D, 0.5f, lastsub ? nullptr : npre + (sub == 0 ? (l * 4 + 1) : ((l + 1) * 4)) * D, X, lastsub ? nullptr : H, 0, TT);
                grid.sync();
            } else if (sub == 1) {
                if ((l & 1) == 0) {
                    { SkS5U e; e.Ub = U;
                      skinny<1>(shm, H + (long)TP * D, D, (const bf16_t*)(ws + O_WSI) + (long)j * M1, D, D, 64, false, 1 << 20, e, 0, 256); }
                    { GD g = gd_plain(H, D, (const bf16_t*)(ws + O_WSI) + (long)j * M1, D, D, 64, 4, D, 256);
                      EpiS5U e; e.Ub = U; gemm_run(lds, g, e, 0); }
                    grid.sync();
                    { GD g = gd_zero(); g.A = U; g.B = (const bf16_t*)(ws + O_W5) + (long)j * 64 * 128 * 256; g.lda = UK; g.ldb = 256; g.nt = 4; g.n = 320; g.d0 = 5; g.d1 = 64; g.d2 = 1;
                      g.sa[0] = (int)(256L * UK); g.sa[1] = (int)(USTRIDE); g.sb[1] = (int)(128L * 256);
                      EpiS5S e; e.Sb = S; gemm_run(lds, g, e, 0); }
                    grid.sync();
                    scan_phase(p, j, shm);
                    grid.sync();
                    { GD g = gd_zero(); g.A = U; g.B = (const bf16_t*)(ws + O_TV) + (long)j * 64 * 256 * UK; g.lda = UK; g.ldb = UK; g.nt = 6; g.n = 320; g.d0 = 5; g.d1 = 64; g.d2 = 1;
                      g.sa[0] = (int)(256L * UK); g.sa[1] = (int)(USTRIDE); g.sb[1] = (int)(256L * UK);
                      EpiS5D e; e.Ub = U; e.dvec = p.in[25] + j * D; e.Zb = Z; gemm_run(lds, g, e, 0); }
                    grid.sync();
                    { SkGLU e; e.C = F + (long)TP * D; e.ldc = D;
                      skinny<2>(shm, Z + (long)TP * D, D, (const bf16_t*)(ws + O_WGL) + (long)j * 2048 * D, D, D, 64, true, 1 << 20, e, 0, 256); }
                    { GD g = gd_plain(Z, D, (const bf16_t*)(ws + O_WGL) + (long)j * 2048 * D, D, D, 64, 8, D, 128);
                      EpiGLU e; e.C = F; e.ldc = D; gemm_run(lds, g, e, 0); }
                    grid.sync();
                } else {
                    { SkF32 e; e.C = F + (long)TP * D; e.ldc = D; e.bias = nullptr; e.scale = nullptr;
                      skinny<1>(shm, H + (long)TP * D, D, (const bf16_t*)(ws + O_WPI) + (long)j * M1, D, D, 64, false, 1 << 20, e, 0, 256); }
                    { GD g = gd_plain(H, D, (const bf16_t*)(ws + O_WPI) + (long)j * M1, D, D, 64, 4, D, 256);
                      EpiF32 e; e.C = F; e.ldc = D; e.bias = nullptr; e.scale = nullptr; gemm_run(lds, g, e, 0); }
                    grid.sync();
                    pool_phase(p, j);
                    grid.sync();
                    { GD g = gd_zero(); g.A = Z; g.B = (const bf16_t*)(ws + O_WGR) + (long)j * 4 * 65536; g.lda = D; g.ldb = 256; g.nt = 4; g.n = 256; g.d0 = 64; g.d1 = 4; g.d2 = 1;
                      g.sa[0] = (int)(256L * D); g.sa[1] = (int)(256); g.sb[1] = (int)(65536); g.sc[0] = (int)(256L * D); g.sc[1] = (int)(256);
                      EpiF32 e; e.C = F; e.ldc = D; e.bias = p.in[30] + j * D; e.scale = p.in[31] + j * D; gemm_run(lds, g, e, 0); }
                    { SkF32 e; e.C = F + (long)TP * D; e.ldc = D; e.bias = p.in[30] + j * D; e.scale = p.in[31] + j * D;
                      skinny<1>(shm, Z + (long)TP * D, D, (const bf16_t*)(ws + O_WGR) + (long)j * 4 * 65536, 256, 256, 64, false, 16, e, 0, 256); }
                    grid.sync();
                }
                rows_phase(X, F, npost + (l * 4 + 1) * D, 1.0f, npre + (l * 4 + 2) * D, X, H, 0, TT);
                grid.sync();
            } else {
                { GD g = gd_zero(); g.A = H; g.B = (const bf16_t*)(ws + O_QK) + (long)l * 2 * M1; g.lda = D; g.ldb = D; g.nt = 16; g.n = 256; g.d0 = 32; g.d1 = 2; g.d2 = 4;
                  g.sa[0] = (int)(256L * D); g.sa[1] = (int)(32L * 256 * D); g.sb[1] = (int)(M1); g.sb[2] = (int)(256L * D); g.sc[0] = (int)(256L * D); g.sc[1] = (int)(32L * 256 * D); g.sc[2] = (int)(256);
                  EpiSoftmax e; e.O = Z; e.ldc = D; e.Xl = (LAS float*)(lds + LDS_X); gemm_run(lds, g, e, 0); }
                { SkBf16 e; e.O = Z + (long)TP * D; e.ldc = D;
                  skinny<1>(shm, H + (long)TP * D, D, (const bf16_t*)(ws + O_WQT) + (long)l * M1, D, D, 64, false, 1 << 20, e, 0, 256); }
                grid.sync();
                { GD g = gd_zero(); g.A = Z; g.B = (const bf16_t*)(ws + O_VW) + (long)l * 2 * M1; g.lda = D; g.ldb = D; g.nt = 16; g.n = 256; g.d0 = 32; g.d1 = 2; g.d2 = 4;
                  g.sa[0] = (int)(256L * D); g.sa[1] = (int)(32L * 256 * D); g.sb[1] = (int)(M1); g.sb[2] = (int)(256L * D); g.sc[0] = (int)(256L * D); g.sc[1] = (int)(32L * 256 * D); g.sc[2] = (int)(256);
                  EpiF32 e; e.C = F; e.ldc = D; e.bias = nullptr; e.scale = nullptr; gemm_run(lds, g, e, 0); }
                sample_attn_phase(p, l, shm);
                grid.sync();
                { SkF32 e; e.C = F + (long)TP * D; e.ldc = D; e.bias = nullptr; e.scale = nullptr;
                  skinny<1>(shm, H + (long)TP * D, D, (const bf16_t*)(ws + O_WOT) + (long)l * M1, D, D, 64, false, 1 << 20, e, 0, 256); }
                grid.sync();
                rows_phase(X, F, npost + (l * 4 + 2) * D, 1.0f, npre + (l * 4 + 3) * D, X, H, 0, TT);
                grid.sync();
            }
        }
    }
}
#undef ws
#undef X
#undef H
#undef Z
#undef F
#undef ACT
#undef U
#undef S
#undef npre
#undef npost

static void add_job(Params& p, int& nj, int& tiles, const float* src, bf16_t* dst, int R, int C, int lds, int ldd, int mode, int nb, long sbs, long dbs) {
    TJob& j = p.jobs[nj++]; j.src = src; j.dst = dst; j.sbs = sbs; j.dbs = dbs; j.lds = lds; j.ldd = ldd; j.tr = R / 64; j.tc = C / 64; j.mode = mode; j.nb = nb; j.tile0 = tiles; j.pad = 0;
    tiles += nb * j.tr * j.tc;
}

extern "C" void kernel_launch(void* const* d_in, const int* in_sizes, int n_in, void* d_out, int out_size, void* d_ws, size_t ws_size, hipStream_t stream) {
    static int grid_blocks = 0;
    if (grid_blocks == 0) {
        if (n_in != 32 || (long)out_size != OUT_TOTAL || ws_size < WS_END) {
            fprintf(stderr, "kernel_launch: unexpected shapes (n_in %d out %d ws %zu need %zu)\n", n_in, out_size, ws_size, (size_t)WS_END); grid_blocks = -1; return; }
        int dev = 0, cus = 0, per_cu = 0;
        hipGetDevice(&dev);
        hipDeviceGetAttribute(&cus, hipDeviceAttributeMultiprocessorCount, dev);
        if (hipFuncSetAttribute((const void*)mega, hipFuncAttributeMaxDynamicSharedMemorySize, LDS_BYTES) != hipSuccess) { fprintf(stderr, "kernel_launch: hipFuncSetAttribute failed\n"); grid_blocks = -1; return; }
        if (hipOccupancyMaxActiveBlocksPerMultiprocessor(&per_cu, (const void*)mega, 512, LDS_BYTES) != hipSuccess || per_cu < 1) { fprintf(stderr, "kernel_launch: occupancy query failed (%d)\n", per_cu); (void)hipGetLastError(); per_cu = 1; }
        grid_blocks = cus * per_cu;
    }
    if (grid_blocks < 0) return;
    Params p; memset(&p, 0, sizeof(p));
    for (int i = 0; i < 32; ++i) p.in[i] = (const float*)d_in[i];
    p.out = (float*)d_out; p.ws = (unsigned char*)d_ws;
    unsigned char* ws = (unsigned char*)d_ws;
    int nj = 0, tiles = 0;
    const long WF = 1024L * 2816;
    add_job(p, nj, tiles, p.in[11], (bf16_t*)(ws + O_WGU), 1024, 2816, 2816, 1024, 1, 8, WF, 5632L * 1024);
    add_job(p, nj, tiles, p.in[12], (bf16_t*)(ws + O_WGU), 1024, 2816, 2816, 1024, 2, 8, WF, 5632L * 1024);
    add_job(p, nj, tiles, p.in[13], (bf16_t*)(ws + O_WDN), 2816, 1024, 1024, 2816, 0, 8, WF, WF);
    add_job(p, nj, tiles, p.in[14], (bf16_t*)(ws + O_WQT), 1024, 1024, 1024, 1024, 0, 4, M1, M1);
    add_job(p, nj, tiles, p.in[14], (bf16_t*)(ws + O_WQP), 1024, 1024, 1024, 1024, 3, 4, M1, M1);
    add_job(p, nj, tiles, p.in[15], (bf16_t*)(ws + O_WKT), 1024, 1024, 1024, 1024, 0, 4, M1, M1);
    add_job(p, nj, tiles, p.in[16], (bf16_t*)(ws + O_WKT) + 4 * M1, 1024, 1024, 1024, 1024, 0, 4, M1, M1);
    add_job(p, nj, tiles, p.in[17], (bf16_t*)(ws + O_WOT), 1024, 1024, 1024, 1024, 0, 4, M1, M1);
    add_job(p, nj, tiles, p.in[18], (bf16_t*)(ws + O_WSI), 1024, 1024, 1024, 1024, 0, 2, M1, M1);
    add_job(p, nj, tiles, p.in[27], (bf16_t*)(ws + O_WGL), 1024, 1024, 2048, 1024, 1, 2, 2 * M1, 2 * M1);
    add_job(p, nj, tiles, p.in[27] + 1024, (bf16_t*)(ws + O_WGL), 1024, 1024, 2048, 1024, 2, 2, 2 * M1, 2 * M1);
    add_job(p, nj, tiles, p.in[28], (bf16_t*)(ws + O_WPI), 1024, 1024, 1024, 1024, 0, 2, M1, M1);
    add_job(p, nj, tiles, p.in[29], (bf16_t*)(ws + O_WGR), 256, 256, 256, 256, 0, 8, 65536, 65536);
    while (nj < NJOBS) { TJob& j = p.jobs[nj++]; j.tile0 = 0x7fffffff; j.tr = 1; j.tc = 1; j.nb = 0; }
    p.ntiles = tiles;
    void* args[] = {(void*)&p};
    hipError_t e = hipLaunchCooperativeKernel((const void*)mega, dim3(grid_blocks), dim3(512), args, LDS_BYTES, stream);
    if (e != hipSuccess) fprintf(stderr, "cooperative launch failed: %s (grid %d)\n", hipGetErrorString(e), grid_blocks);
}
```

```cpp
#include <hip/hip_runtime.h>
#include <hip/hip_cooperative_groups.h>
#include <cstdio>
#include <cstring>
namespace cg = cooperative_groups;

#define LAS __attribute__((address_space(3)))
typedef unsigned short bf16_t;
typedef short bf16x8 __attribute__((ext_vector_type(8)));
typedef float f32x4 __attribute__((ext_vector_type(4)));
typedef unsigned u32x4 __attribute__((ext_vector_type(4)));
typedef unsigned u32x2 __attribute__((ext_vector_type(2)));

constexpr int D = 1024, DFF = 2816, TP = 16384, TT = 16640;
constexpr int CR = 1040, UK = 384;
constexpr long USTRIDE = (long)CR * UK;
constexpr float EPS = 1e-6f;
constexpr long M1 = 1024 * 1024;

constexpr size_t AL(size_t x) { return (x + 255) & ~(size_t)255; }
constexpr size_t O_WGU = 0;
constexpr size_t O_WDN = O_WGU + AL((size_t)8 * 5632 * 1024 * 2);
constexpr size_t O_WQT = O_WDN + AL((size_t)8 * 1024 * 2816 * 2);
constexpr size_t O_WOT = O_WQT + AL((size_t)4 * M1 * 2);
constexpr size_t O_WSI = O_WOT + AL((size_t)4 * M1 * 2);
constexpr size_t O_WPI = O_WSI + AL((size_t)2 * M1 * 2);
constexpr size_t O_WGL = O_WPI + AL((size_t)2 * M1 * 2);
constexpr size_t O_WGR = O_WGL + AL((size_t)2 * 2048 * 1024 * 2);
constexpr size_t O_TV  = O_WGR + AL((size_t)2 * 4 * 65536 * 2);
constexpr size_t O_W5  = O_TV + AL((size_t)2 * 64 * 256 * UK * 2);
constexpr size_t O_QK  = O_W5 + AL((size_t)2 * 64 * 128 * 256 * 2 + 128 * 256 * 2);
constexpr size_t O_VW  = O_QK + AL((size_t)8 * M1 * 2);
constexpr size_t O_LAM = O_VW + AL((size_t)8 * M1 * 2);
constexpr size_t O_BAR = O_LAM + AL((size_t)2 * 64 * 64 * 4 * 4);
constexpr size_t O_H   = O_BAR + AL((size_t)4096 * 4);
constexpr size_t O_Z   = O_H + AL((size_t)TT * D * 2);
constexpr size_t O_F   = O_Z + AL((size_t)TT * D * 2);
constexpr size_t O_ACT = O_F + AL((size_t)TT * D * 4);
constexpr size_t WS_END = O_ACT + AL((size_t)TT * DFF * 2);
constexpr size_t O_U   = O_ACT;
constexpr size_t O_S   = O_U + AL((size_t)64 * USTRIDE * 2 + 256 * UK * 2);
static_assert(O_S + (size_t)64 * CR * 128 * 4 <= WS_END, "U/S alias overflow");
constexpr size_t O_WKT = O_ACT;
constexpr size_t O_WQP = O_WKT + (size_t)8 * M1 * 2;
constexpr size_t O_AMEM = O_WQP + (size_t)4 * M1 * 2;
constexpr size_t O_KBF = O_AMEM + (size_t)4 * 512 * 1024 * 2;
static_assert(O_KBF + (size_t)8 * 512 * 1024 * 2 <= WS_END, "prep alias overflow");

constexpr long OO_MEMK = (long)TT * D;
constexpr long OO_SRP = OO_MEMK + 2 * 2097152L;
constexpr long OO_SIP = OO_SRP + 16384;
constexpr long OO_PP = OO_SIP + 16384;
constexpr long OO_SRS = OO_PP + 61440;
constexpr long OO_SIS = OO_SRS + 65536;
constexpr long OO_PS = OO_SIS + 65536;
constexpr long OUT_TOTAL = OO_PS + 245760;

struct TJob { const float* src; bf16_t* dst; long sbs, dbs; int lds, ldd, tr, tc, mode, nb, tile0, pad; };
constexpr int NJOBS = 14;
struct Params {
    const float* in[32];
    float* out;
    unsigned char* ws;
    TJob jobs[NJOBS];
    int ntiles, pad;
};

__device__ __forceinline__ unsigned char* opq_ptr(unsigned char* x) {
    unsigned lo = (unsigned)(unsigned long long)x, hi = (unsigned)((unsigned long long)x >> 32);
    asm volatile("" : "+v"(lo), "+v"(hi));
    lo = __builtin_amdgcn_readfirstlane(lo); hi = __builtin_amdgcn_readfirstlane(hi);
    return (unsigned char*)(((unsigned long long)hi << 32) | lo); }
__device__ __forceinline__ int opaque_tid() { int t = threadIdx.x; asm volatile("" : "+v"(t)); return t; }
__device__ __forceinline__ unsigned cvt_pk_bf16(float lo, float hi) { unsigned r; asm volatile("v_cvt_pk_bf16_f32 %0, %1, %2" : "=v"(r) : "v"(lo), "v"(hi)); return r; }
__device__ __forceinline__ float bf2f(unsigned short b) { return __uint_as_float(((unsigned)b) << 16); }
__device__ __forceinline__ float shx(float v, int mask, int lane) { return __int_as_float(__builtin_amdgcn_ds_bpermute((lane ^ mask) << 2, __float_as_int(v))); }
__device__ __forceinline__ float wave_sum(float v, int lane) {
#pragma unroll
    for (int o = 1; o < 64; o <<= 1) v += shx(v, o, lane);
    return v;
}
__device__ __forceinline__ float wave_max(float v, int lane) {
#pragma unroll
    for (int o = 1; o < 64; o <<= 1) v = fmaxf(v, shx(v, o, lane));
    return v;
}
__device__ __forceinline__ float fsigmoid(float x) { return __builtin_amdgcn_rcpf(1.0f + __expf(-x)); }
__device__ __forceinline__ float gelu_tanh(float y) {
    const float t = 0.7978845608028654f * (y + 0.044715f * y * y * y);
    return y * fsigmoid(2.0f * t);
}

#define XB_TMO      128
#define XB_XCNT(j)  (256  + 64 * (j))
#define XB_XSUB(j)  (1280 + 64 * (j))
#define XB_XGEN(j)  (2304 + 64 * (j))
#define XB_TOP      3328
#define XB_TOPGEN   3392
#define XCD_BAR_WORDS 3456
#define XB_SPIN_CAP (1u << 18)

__device__ __forceinline__ unsigned xb_ld(unsigned* p)              { return __hip_atomic_load(p, __ATOMIC_RELAXED, __HIP_MEMORY_SCOPE_AGENT); }
__device__ __forceinline__ unsigned xb_add(unsigned* p, unsigned v) { return __hip_atomic_fetch_add(p, v, __ATOMIC_RELAXED, __HIP_MEMORY_SCOPE_AGENT); }
__device__ __forceinline__ unsigned xb_xcc_id() { return (unsigned)__builtin_amdgcn_s_getreg((3 << 11) | 20) & 0xFu; }
#define XB_SPIN(cond, bar) do { unsigned _sp = 0; while (cond) { __builtin_amdgcn_s_sleep(1); \
    if ((++_sp & 255u) == 0u) { if (xb_ld(&(bar)[XB_TMO])) break; if (_sp > XB_SPIN_CAP) { atomicAdd(&(bar)[XB_TMO], 1u); break; } } } } while (0)

struct XcdBarrier {
    unsigned* bar; unsigned x;
    volatile LAS unsigned* st;
};

__device__ __forceinline__ XcdBarrier xcd_barrier_post(unsigned* bar, volatile LAS unsigned* st) {
    XcdBarrier b; b.bar = bar; b.x = xb_xcc_id(); b.st = st;
    if (threadIdx.x == 0) (void)xb_add(&bar[XB_XCNT(b.x)], 1u);
    return b;
}
__device__ __forceinline__ void xcd_barrier_complete(unsigned* bar, unsigned x, unsigned& nloc, unsigned& nx) {
    const unsigned G = gridDim.x * gridDim.y * gridDim.z;
    unsigned sum, cnt, mine, sp = 0u;
    for (;;) {
        sum = 0u; cnt = 0u; mine = 0u;
#pragma unroll
        for (unsigned j = 0; j < 16; ++j) { const unsigned c = xb_ld(&bar[XB_XCNT(j)]); sum += c; cnt += (c > 0u) ? 1u : 0u; mine = (j == x) ? c : mine; }
        if (sum == G) break;
        __builtin_amdgcn_s_sleep(1);
        if ((++sp & 255u) == 0u) { if (xb_ld(&bar[XB_TMO])) break; if (sp > XB_SPIN_CAP) { atomicAdd(&bar[XB_TMO], 1u); break; } }
    }
    nloc = mine > 0u ? mine : 1u; nx = cnt > 0u ? cnt : 1u;
}

__device__ __forceinline__ void xcd_barrier(const XcdBarrier& b) {
    asm volatile("s_waitcnt vmcnt(0)" ::: "memory");
    __syncthreads();
    if (opaque_tid() == 0) {
        unsigned* bar = b.bar; unsigned bx = xb_xcc_id(); asm volatile("" : "+s"(bx));
        __builtin_amdgcn_s_waitcnt(0);
        unsigned nloc = b.st[0], nx = b.st[1];
        if (nloc == 0u) { xcd_barrier_complete(bar, bx, nloc, nx); b.st[0] = nloc; b.st[1] = nx; }
        const unsigned old = xb_add(&bar[XB_XSUB(bx)], 1u);
        const unsigned gen = old / nloc;
        if (old + 1u == (gen + 1u) * nloc) {
            __builtin_amdgcn_fence(__ATOMIC_RELEASE, "agent");
            asm volatile("s_waitcnt vmcnt(0)" ::: "memory");
            const unsigned og = xb_add(&bar[XB_TOP], 1u);
            const unsigned tg = og / nx;
            if (og + 1u == (tg + 1u) * nx) xb_add(&bar[XB_TOPGEN], 1u);
            else XB_SPIN(xb_ld(&bar[XB_TOPGEN]) == tg, bar);
            __builtin_amdgcn_fence(__ATOMIC_ACQUIRE, "agent");
            xb_add(&bar[XB_XGEN(bx)], 1u);
            asm volatile("s_waitcnt vmcnt(0)" ::: "memory");
        } else {
            XB_SPIN(xb_ld(&bar[XB_XGEN(bx)]) == gen, bar);
            __builtin_amdgcn_fence(__ATOMIC_ACQUIRE, "agent");
            asm volatile("s_waitcnt vmcnt(0)" ::: "memory");
        }
    }
    __syncthreads();
}


constexpr int BM = 256, BK = 64, HALF = 128, HTB = HALF * BK * 2, STAGE_BYTES = 8 * HTB;
constexpr int LDS_X = STAGE_BYTES;
constexpr int LDS_ST = STAGE_BYTES + 8192;
constexpr int LDS_BYTES = STAGE_BYTES + 8192 + 64;
__device__ __forceinline__ int lds_byte(int r, int c) { const int st = (r >> 4) * 2 + (c >> 5), rr = r & 15, cc = c & 31, ob = rr * 64 + cc * 2; return st * 1024 + (ob ^ (((ob >> 9) & 1) << 5)); }
__device__ __forceinline__ void stage_rc(int b, int& R, int& C) { const int st = b / 1024, sb = b % 1024, swz = sb ^ (((sb >> 9) & 1) << 5); R = (st >> 1) * 16 + swz / 64; C = (st & 1) * 32 + (swz % 64) / 2; }
__device__ __forceinline__ int perm32(int rho) { const int n = rho >> 4, i = rho & 15; return 8 * (i >> 2) + 4 * n + (i & 3); }

struct Unit { const char* a; const char* b; long c; int i0, i1, i2, i3; };
struct GD {
    const bf16_t* A; const bf16_t* B; int lda, ldb, nt, n, d0, d1, d2; int sa[4], sb[4], sc[4];
    __device__ __forceinline__ bool unit(long L, Unit& u) const {
        if (L >= n) return false;
        int l = (int)L; const int i0 = l % d0; l /= d0; const int i1 = l % d1; l /= d1; const int i2 = l % d2; const int i3 = l / d2;
        u.i0 = i0; u.i1 = i1; u.i2 = i2; u.i3 = i3;
        u.a = (const char*)(A + (long)(i0 * sa[0] + i1 * sa[1] + i2 * sa[2] + i3 * sa[3]));
        u.b = (const char*)(B + (long)(i0 * sb[0] + i1 * sb[1] + i2 * sb[2] + i3 * sb[3]));
        u.c = (long)(i0 * sc[0] + i1 * sc[1] + i2 * sc[2] + i3 * sc[3]);
        return true;
    }
};
__device__ __forceinline__ GD gd_zero() { GD g; g.A = nullptr; g.B = nullptr; g.lda = g.ldb = 0; g.nt = 0; g.n = 0; g.d0 = g.d1 = g.d2 = 1;
    for (int i = 0; i < 4; ++i) { g.sa[i] = 0; g.sb[i] = 0; g.sc[i] = 0; } return g; }
__device__ __forceinline__ GD gd_plain(const bf16_t* A, int lda, const bf16_t* B, int ldb, int K, int nM, int nN, int ldc, int ctile) {
    GD g = gd_zero(); g.A = A; g.B = B; g.lda = lda; g.ldb = ldb; g.nt = K / BK; g.n = nM * nN; g.d0 = nM; g.d1 = nN; g.d2 = 1;
    g.sa[0] = 256 * lda; g.sb[1] = 256 * ldb; g.sc[0] = 256 * ldc; g.sc[1] = ctile; return g; }

typedef f32x4 Acc[2][2][4][2];

struct EpiF32 {
    static constexpr bool PERM = false;
    float* C; int ldc; const float* bias; const float* scale;
    __device__ __forceinline__ void operator()(const Acc& acc, const Unit& u, int wr, int wc, int fr, int fq) const {
        const int cb = (int)(u.c % ldc);
        const int row0 = wr * 64 + fr, col0 = wc * 32 + 4 * fq;
        f32x4 bv[2][2], sv[2][2];
#pragma unroll
        for (int bj = 0; bj < 2; ++bj)
#pragma unroll
            for (int n = 0; n < 2; ++n) {
                bv[bj][n] = bias ? *(const f32x4*)(bias + cb + col0 + bj * HALF + n * 16) : (f32x4){0.f, 0.f, 0.f, 0.f};
                sv[bj][n] = scale ? *(const f32x4*)(scale + cb + col0 + bj * HALF + n * 16) : (f32x4){1.f, 1.f, 1.f, 1.f}; }
#pragma unroll
        for (int ai = 0; ai < 2; ++ai)
#pragma unroll
            for (int m = 0; m < 4; ++m) { float* rowp = C + u.c + (long)(row0 + ai * HALF + m * 16) * ldc + col0;
#pragma unroll
                for (int bj = 0; bj < 2; ++bj)
#pragma unroll
                    for (int n = 0; n < 2; ++n) *(f32x4*)(rowp + bj * HALF + n * 16) = (acc[ai][bj][m][n] + bv[bj][n]) * sv[bj][n]; }
    }
};
struct EpiF32Bf16 {
    static constexpr bool PERM = false;
    float* C; bf16_t* O; int ldc;
    __device__ __forceinline__ void operator()(const Acc& acc, const Unit& u, int wr, int wc, int fr, int fq) const {
        const int row0 = wr * 64 + fr, col0 = wc * 32 + 4 * fq;
#pragma unroll
        for (int ai = 0; ai < 2; ++ai)
#pragma unroll
            for (int m = 0; m < 4; ++m) { const long off = u.c + (long)(row0 + ai * HALF + m * 16) * ldc + col0;
#pragma unroll
                for (int bj = 0; bj < 2; ++bj)
#pragma unroll
                    for (int n = 0; n < 2; ++n) { const f32x4 v = acc[ai][bj][m][n]; *(f32x4*)(C + off + bj * HALF + n * 16) = v;
                        u32x2 w; w.x = cvt_pk_bf16(v[0], v[1]); w.y = cvt_pk_bf16(v[2], v[3]); *(u32x2*)(O + off + bj * HALF + n * 16) = w; } }
    }
};
struct EpiBf16 {
    static constexpr bool PERM = true;
    bf16_t* O; int ldc; float s;
    __device__ __forceinline__ void operator()(const Acc& acc, const Unit& u, int wr, int wc, int fr, int fq) const {
        const int row0 = wr * 64 + fr, col0 = wc * 32 + 8 * fq;
#pragma unroll
        for (int ai = 0; ai < 2; ++ai)
#pragma unroll
            for (int m = 0; m < 4; ++m) { bf16_t* rowp = O + u.c + (long)(row0 + ai * HALF + m * 16) * ldc + col0;
#pragma unroll
                for (int bj = 0; bj < 2; ++bj) { const f32x4 v0 = acc[ai][bj][m][0] * s, v1 = acc[ai][bj][m][1] * s;
                    u32x4 w; w.x = cvt_pk_bf16(v0[0], v0[1]); w.y = cvt_pk_bf16(v0[2], v0[3]); w.z = cvt_pk_bf16(v1[0], v1[1]); w.w = cvt_pk_bf16(v1[2], v1[3]);
                    *(u32x4*)(rowp + bj * HALF) = w; } }
    }
};
struct EpiSwiGLU {
    static constexpr bool PERM = true;
    bf16_t* O; int ldc;
    __device__ __forceinline__ void operator()(const Acc& acc, const Unit& u, int wr, int wc, int fr, int fq) const {
        const int row0 = wr * 64 + fr, col0 = wc * 32 + 8 * fq;
#pragma unroll
        for (int ai = 0; ai < 2; ++ai)
#pragma unroll
            for (int m = 0; m < 4; ++m) { bf16_t* rowp = O + u.c + (long)(row0 + ai * HALF + m * 16) * ldc + col0;
                float r[8];
#pragma unroll
                for (int n = 0; n < 2; ++n)
#pragma unroll
                    for (int j = 0; j < 4; ++j) { const float g = acc[ai][0][m][n][j], up = acc[ai][1][m][n][j]; r[n * 4 + j] = g * fsigmoid(g) * up; }
                u32x4 w; w.x = cvt_pk_bf16(r[0], r[1]); w.y = cvt_pk_bf16(r[2], r[3]); w.z = cvt_pk_bf16(r[4], r[5]); w.w = cvt_pk_bf16(r[6], r[7]);
                *(u32x4*)rowp = w; }
    }
};
struct EpiGLU {
    static constexpr bool PERM = false;
    float* C; int ldc;
    __device__ __forceinline__ void operator()(const Acc& acc, const Unit& u, int wr, int wc, int fr, int fq) const {
        const int row0 = wr * 64 + fr, col0 = wc * 32 + 4 * fq;
#pragma unroll
        for (int ai = 0; ai < 2; ++ai)
#pragma unroll
            for (int m = 0; m < 4; ++m) { float* rowp = C + u.c + (long)(row0 + ai * HALF + m * 16) * ldc + col0;
#pragma unroll
                for (int n = 0; n < 2; ++n) { f32x4 o;
#pragma unroll
                    for (int j = 0; j < 4; ++j) o[j] = acc[ai][0][m][n][j] * fsigmoid(acc[ai][1][m][n][j]);
                    *(f32x4*)(rowp + n * 16) = o; } }
    }
};
struct EpiS5U {
    static constexpr bool PERM = true;
    bf16_t* Ub;
    __device__ __forceinline__ void operator()(const Acc& acc, const Unit& u, int wr, int wc, int fr, int fq) const {
#pragma unroll
        for (int ai = 0; ai < 2; ++ai)
#pragma unroll
            for (int m = 0; m < 4; ++m) { const int tok = u.i0 * 256 + ai * HALF + wr * 64 + m * 16 + fr;
#pragma unroll
                for (int bj = 0; bj < 2; ++bj) { const int g = u.i1 * 16 + 8 * bj + 2 * wc + (fq >> 1);
                    bf16_t* dst = Ub + (long)g * USTRIDE + (long)(tok >> 4) * UK + (tok & 15) * 16 + (fq & 1) * 8;
                    const f32x4 v0 = acc[ai][bj][m][0], v1 = acc[ai][bj][m][1];
                    u32x4 w; w.x = cvt_pk_bf16(v0[0], v0[1]); w.y = cvt_pk_bf16(v0[2], v0[3]); w.z = cvt_pk_bf16(v1[0], v1[1]); w.w = cvt_pk_bf16(v1[2], v1[3]);
                    *(u32x4*)dst = w; } }
    }
};
struct EpiS5S {
    static constexpr bool PERM = false;
    float* Sb;
    __device__ __forceinline__ void operator()(const Acc& acc, const Unit& u, int wr, int wc, int fr, int fq) const {
#pragma unroll
        for (int ai = 0; ai < 2; ++ai)
#pragma unroll
            for (int m = 0; m < 4; ++m) { const int row = u.i0 * 256 + ai * HALF + wr * 64 + m * 16 + fr;
                if (row < CR) { float* rowp = Sb + ((long)u.i1 * CR + row) * 128 + wc * 32 + 4 * fq;
#pragma unroll
                    for (int n = 0; n < 2; ++n) *(f32x4*)(rowp + n * 16) = acc[ai][0][m][n]; } }
    }
};
struct EpiS5D {
    static constexpr bool PERM = true;
    const bf16_t* Ub; const float* dvec; bf16_t* Zb;
    __device__ __forceinline__ void operator()(const Acc& acc, const Unit& u, int wr, int wc, int fr, int fq) const {
        const int g = u.i1, c0 = (fq & 1) * 8;
        const f32x4 d0 = *(const f32x4*)(dvec + g * 16 + c0), d1 = *(const f32x4*)(dvec + g * 16 + c0 + 4);
#pragma unroll
        for (int ai = 0; ai < 2; ++ai)
#pragma unroll
            for (int m = 0; m < 4; ++m) { const int row = u.i0 * 256 + ai * HALF + wr * 64 + m * 16 + fr;
                if (row < CR) {
#pragma unroll
                    for (int bj = 0; bj < 2; ++bj) { const int jt = 8 * bj + 2 * wc + (fq >> 1);
                        const u32x4 uu = *(const u32x4*)(Ub + (long)g * USTRIDE + (long)row * UK + jt * 16 + c0);
                        float y[8];
#pragma unroll
                        for (int q = 0; q < 4; ++q) { const unsigned w = uu[q]; const float ulo = __uint_as_float(w << 16), uhi = __uint_as_float(w & 0xffff0000u);
                            const float dl = (q < 2) ? d0[2 * q] : d1[2 * q - 4], dh = (q < 2) ? d0[2 * q + 1] : d1[2 * q - 3];
                            const float al = (q < 2) ? acc[ai][bj][m][0][2 * q] : acc[ai][bj][m][1][2 * q - 4], ah = (q < 2) ? acc[ai][bj][m][0][2 * q + 1] : acc[ai][bj][m][1][2 * q - 3];
                            y[2 * q] = gelu_tanh(al + dl * ulo); y[2 * q + 1] = gelu_tanh(ah + dh * uhi); }
                        u32x4 w; w.x = cvt_pk_bf16(y[0], y[1]); w.y = cvt_pk_bf16(y[2], y[3]); w.z = cvt_pk_bf16(y[4], y[5]); w.w = cvt_pk_bf16(y[6], y[7]);
                        *(u32x4*)(Zb + (long)(row * 16 + jt) * D + g * 16 + c0) = w; } } }
    }
};
struct EpiSoftmax {
    static constexpr bool PERM = true;
    bf16_t* O; int ldc; LAS float* Xl;
    __device__ __forceinline__ void operator()(const Acc& acc, const Unit& u, int wr, int wc, int fr, int fq) const {
        float mx[2][4]; const int ln = fr + 16 * fq;
#pragma unroll
        for (int ai = 0; ai < 2; ++ai)
#pragma unroll
            for (int m = 0; m < 4; ++m) { float a = -3.0e38f;
#pragma unroll
                for (int bj = 0; bj < 2; ++bj)
#pragma unroll
                    for (int n = 0; n < 2; ++n)
#pragma unroll
                        for (int j = 0; j < 4; ++j) a = fmaxf(a, acc[ai][bj][m][n][j]);
                a = fmaxf(a, shx(a, 16, ln)); a = fmaxf(a, shx(a, 32, ln));
                float s = 0.f;
#pragma unroll
                for (int bj = 0; bj < 2; ++bj)
#pragma unroll
                    for (int n = 0; n < 2; ++n)
#pragma unroll
                        for (int j = 0; j < 4; ++j) s += __expf(acc[ai][bj][m][n][j] - a);
                s += shx(s, 16, ln); s += shx(s, 32, ln);
                mx[ai][m] = a;
                const int r = ai * HALF + wr * 64 + m * 16 + fr;
                if (fq == 0) { Xl[(r * 4 + wc) * 2] = a; Xl[(r * 4 + wc) * 2 + 1] = s; } }
        asm volatile("s_waitcnt lgkmcnt(0)" ::: "memory"); __builtin_amdgcn_s_barrier(); asm volatile("" ::: "memory");
#pragma unroll
        for (int ai = 0; ai < 2; ++ai)
#pragma unroll
            for (int m = 0; m < 4; ++m) { const int r = ai * HALF + wr * 64 + m * 16 + fr;
                const f32x4 p0 = *(const LAS f32x4*)(Xl + r * 8), p1 = *(const LAS f32x4*)(Xl + r * 8 + 4);
                const float M = fmaxf(fmaxf(p0[0], p0[2]), fmaxf(p1[0], p1[2]));
                const float Ls = p0[1] * __expf(p0[0] - M) + p0[3] * __expf(p0[2] - M) + p1[1] * __expf(p1[0] - M) + p1[3] * __expf(p1[2] - M);
                const float inv = __builtin_amdgcn_rcpf(Ls);
                bf16_t* rowp = O + u.c + (long)r * ldc + wc * 32 + 8 * fq;
#pragma unroll
                for (int bj = 0; bj < 2; ++bj) { float e[8];
#pragma unroll
                    for (int n = 0; n < 2; ++n)
#pragma unroll
                        for (int j = 0; j < 4; ++j) e[n * 4 + j] = __expf(acc[ai][bj][m][n][j] - M) * inv;
                    u32x4 w; w.x = cvt_pk_bf16(e[0], e[1]); w.y = cvt_pk_bf16(e[2], e[3]); w.z = cvt_pk_bf16(e[4], e[5]); w.w = cvt_pk_bf16(e[6], e[7]);
                    *(u32x4*)(rowp + bj * HALF) = w; } }
        (void)mx;
    }
};

template <class Epi>
__device__ __forceinline__ void gemm_run(LAS unsigned char* lds, const GD g, const Epi& E, int rot) {
    const int tid = opaque_tid(), wid = __builtin_amdgcn_readfirstlane(tid >> 6), lane = tid & 63, wr = wid >> 2, wc = wid & 3, fr = lane & 15, fq = lane >> 4;
    const int nt = g.nt, G = gridDim.x;
    int cblk = blockIdx.x; asm volatile("" : "+s"(cblk)); cblk += rot; if (cblk >= G) cblk -= G;
    unsigned voffA[2], voffB[2];
#pragma unroll
    for (int i = 0; i < 2; ++i) { int R, C; stage_rc(tid * 16 + i * 8192, R, C); const int Rb = Epi::PERM ? ((R & ~31) + perm32(R & 31)) : R;
        voffA[i] = (unsigned)(R * g.lda + C) * 2u; voffB[i] = (unsigned)(Rb * g.ldb + C) * 2u; }
    const size_t kstep = (size_t)(BK * 2);
    const size_t hstepA = (size_t)HALF * g.lda * 2, hstepB = (size_t)HALF * g.ldb * 2;
    const unsigned ldsw = (unsigned)wid * 1024u;
    const int aoff = lds_byte(wr * 64 + fr, fq * 8), boff = lds_byte(wc * 32 + fr, fq * 8);
#define PG8_SA(b, h) (((b) * 2 + (h)) * HTB)
#define PG8_SB(b, h) ((4 + (b) * 2 + (h)) * HTB)
#define PG8_STAGE(bufoff, gbase, voff) do { _Pragma("unroll") for (int _i = 0; _i < 2; ++_i) \
        __builtin_amdgcn_global_load_lds((const unsigned*)((const char*)(gbase) + (voff)[_i]), (LAS unsigned*)(lds + (bufoff) + ldsw + _i * 8192), 16, 0, 0); } while (0)
#define PG8_LDA(dst, b, h) do { _Pragma("unroll") for (int m = 0; m < 4; ++m) _Pragma("unroll") for (int k = 0; k < 2; ++k) dst[m][k] = *(const LAS bf16x8*)(lds + PG8_SA(b, h) + aoff + m * 2048 + k * 1024); } while (0)
#define PG8_LDB(dst, b, h) do { _Pragma("unroll") for (int n = 0; n < 2; ++n) _Pragma("unroll") for (int k = 0; k < 2; ++k) dst[n][k] = *(const LAS bf16x8*)(lds + PG8_SB(b, h) + boff + n * 2048 + k * 1024); } while (0)
#define PG8_MMA(ai, bj, At, Bt) do { __builtin_amdgcn_s_setprio(1); _Pragma("unroll") for (int m = 0; m < 4; ++m) _Pragma("unroll") for (int n = 0; n < 2; ++n) _Pragma("unroll") for (int k = 0; k < 2; ++k) \
        acc[ai][bj][m][n] = __builtin_amdgcn_mfma_f32_16x16x32_bf16(Bt[n][k], At[m][k], acc[ai][bj][m][n], 0, 0, 0); __builtin_amdgcn_s_setprio(0); } while (0)
#define PG8_WAIT_V(n) asm volatile("s_waitcnt vmcnt(" #n ")" ::: "memory")
#define PG8_WAIT_L(n) asm volatile("s_waitcnt lgkmcnt(" #n ")" ::: "memory")
#define PG8_BAR __builtin_amdgcn_s_barrier()
#define PG8_SCHED __builtin_amdgcn_sched_barrier(0)
    Unit cur, nxt; int ui = 0;
    if (!g.unit(cblk, cur)) return;
    Acc acc;
#pragma unroll
    for (int a = 0; a < 2; ++a)
#pragma unroll
        for (int b = 0; b < 2; ++b)
#pragma unroll
            for (int m = 0; m < 4; ++m)
#pragma unroll
                for (int n = 0; n < 2; ++n) acc[a][b][m][n] = (f32x4){0.f, 0.f, 0.f, 0.f};
    bf16x8 At[4][2], B0[2][2], B1[2][2];
    const char* cA = cur.a; const char* cB = cur.b;
    PG8_STAGE(PG8_SB(0, 0), cB, voffB); PG8_STAGE(PG8_SA(0, 0), cA, voffA); PG8_STAGE(PG8_SB(0, 1), cB + hstepB, voffB); PG8_STAGE(PG8_SA(0, 1), cA + hstepA, voffA);
    if (wr == 1) PG8_BAR;
    PG8_WAIT_V(4); PG8_BAR;
    PG8_STAGE(PG8_SB(1, 0), cB + kstep, voffB); PG8_STAGE(PG8_SA(1, 0), cA + kstep, voffA); PG8_STAGE(PG8_SB(1, 1), cB + hstepB + kstep, voffB);
    PG8_WAIT_V(6); PG8_BAR;
    for (;;) {
        const bool has_next = g.unit((long)(ui + 1) * G + cblk, nxt);
        const char* nA = has_next ? nxt.a : cA; const char* nB = has_next ? nxt.b : cB;
        for (int t = 0; t < nt; t += 2) {
            const bool last = (t == nt - 2);
            const char* a1 = cA + (size_t)(t + 1) * kstep;
            const char* a2 = last ? nA : cA + (size_t)(t + 2) * kstep; const char* b2 = last ? nB : cB + (size_t)(t + 2) * kstep;
            const char* a3 = a2 + kstep; const char* b3 = b2 + kstep;
            PG8_LDB(B0, 0, 0); PG8_SCHED; PG8_LDA(At, 0, 0); PG8_STAGE(PG8_SA(1, 1), a1 + hstepA, voffA);
            PG8_WAIT_L(8); PG8_BAR; PG8_WAIT_L(0); PG8_MMA(0, 0, At, B0); PG8_BAR; PG8_SCHED;
            PG8_LDB(B1, 0, 1); PG8_STAGE(PG8_SB(0, 0), b2, voffB);
            PG8_BAR; PG8_WAIT_L(0); PG8_MMA(0, 1, At, B1); PG8_BAR;
            PG8_LDA(At, 0, 1); PG8_STAGE(PG8_SA(0, 0), a2, voffA);
            PG8_BAR; PG8_WAIT_L(0); PG8_MMA(1, 0, At, B0); PG8_BAR; PG8_SCHED;
            PG8_STAGE(PG8_SB(0, 1), b2 + hstepB, voffB);
            PG8_WAIT_V(6); PG8_BAR; PG8_MMA(1, 1, At, B1); PG8_BAR;
            PG8_LDB(B0, 1, 0); PG8_SCHED; PG8_LDA(At, 1, 0); PG8_STAGE(PG8_SA(0, 1), a2 + hstepA, voffA);
            PG8_WAIT_L(8); PG8_BAR; PG8_WAIT_L(0); PG8_MMA(0, 0, At, B0); PG8_BAR; PG8_SCHED;
            PG8_LDB(B1, 1, 1); PG8_STAGE(PG8_SB(1, 0), b3, voffB);
            PG8_BAR; PG8_WAIT_L(0); PG8_MMA(0, 1, At, B1); PG8_BAR;
            PG8_LDA(At, 1, 1); PG8_STAGE(PG8_SA(1, 0), a3, voffA);
            PG8_BAR; PG8_WAIT_L(0); PG8_MMA(1, 0, At, B0); PG8_BAR; PG8_SCHED;
            PG8_STAGE(PG8_SB(1, 1), b3 + hstepB, voffB);
            PG8_WAIT_V(6); PG8_BAR; PG8_MMA(1, 1, At, B1); PG8_BAR;
        }
        E(acc, cur, wr, wc, fr, fq);
        if (!has_next) break;
#pragma unroll
        for (int a = 0; a < 2; ++a)
#pragma unroll
            for (int b = 0; b < 2; ++b)
#pragma unroll
                for (int m = 0; m < 4; ++m)
#pragma unroll
                    for (int n = 0; n < 2; ++n) acc[a][b][m][n] = (f32x4){0.f, 0.f, 0.f, 0.f};
        cur = nxt; cA = nA; cB = nB; ++ui;
    }
    PG8_WAIT_V(0);
    if (wr == 0) PG8_BAR;
    PG8_BAR;
#undef PG8_SA
#undef PG8_SB
#undef PG8_STAGE
#undef PG8_LDA
#undef PG8_LDB
#undef PG8_MMA
#undef PG8_WAIT_V
#undef PG8_WAIT_L
#undef PG8_BAR
#undef PG8_SCHED
}


struct SkF32 { float* C; int ldc; const float* bias; const float* scale;
    __device__ __forceinline__ void operator()(int row, int col, const float (&v)[2][2]) const {
#pragma unroll
        for (int q = 0; q < 2; ++q) { const float b = bias ? bias[col + q] : 0.f, sc = scale ? scale[col + q] : 1.f; C[(long)row * ldc + col + q] = (v[0][q] + b) * sc; } } };
struct SkBf16 { bf16_t* O; int ldc;
    __device__ __forceinline__ void operator()(int row, int col, const float (&v)[2][2]) const { *(unsigned*)(O + (long)row * ldc + col) = cvt_pk_bf16(v[0][0], v[0][1]); } };
struct SkSwiGLU { bf16_t* O; int ldc;
    __device__ __forceinline__ void operator()(int row, int col, const float (&v)[2][2]) const {
        *(unsigned*)(O + (long)row * ldc + col) = cvt_pk_bf16(v[0][0] * fsigmoid(v[0][0]) * v[1][0], v[0][1] * fsigmoid(v[0][1]) * v[1][1]); } };
struct SkGLU { float* C; int ldc;
    __device__ __forceinline__ void operator()(int row, int col, const float (&v)[2][2]) const {
        C[(long)row * ldc + col] = v[0][0] * fsigmoid(v[1][0]); C[(long)row * ldc + col + 1] = v[0][1] * fsigmoid(v[1][1]); } };
struct SkS5U { bf16_t* Ub;
    __device__ __forceinline__ void operator()(int row, int col, const float (&v)[2][2]) const { const int tok = TP + row, g = col >> 4;
        *(unsigned*)(Ub + (long)g * USTRIDE + (long)(tok >> 4) * UK + (tok & 15) * 16 + (col & 15)) = cvt_pk_bf16(v[0][0], v[0][1]); } };

template <int NT, class Epi>
__device__ __forceinline__ void skinny(unsigned char* shm, const bf16_t* A, int lda, const bf16_t* B, int ldb, int K, int ncg, bool pair, int agd, const Epi& E, int cu0, int ncu) {
    float* red = (float*)shm;
    const int tid = opaque_tid(), wid = tid >> 6, lane = tid & 63, fr = lane & 15, fq = lane >> 4;
    int cblk = blockIdx.x; asm volatile("" : "+s"(cblk));
    cblk -= cu0; if (cblk < 0 || cblk >= ncu) return;
    const int kslice = K >> 3, steps = kslice >> 5, nitems = 4 * ncg;
    for (int item = cblk; item < nitems; item += ncu) {
        const int rb = item & 3, cgi = item >> 2;
        const int brow = pair ? ((cgi >> 3) * 256 + (cgi & 7) * 16) : cgi * 16;
        const bf16_t* ap = A + (long)(rb * 64 + fr) * lda + (cgi / agd) * 256 + wid * kslice + fq * 8;
        const bf16_t* bp = B + (long)(brow + fr) * ldb + wid * kslice + fq * 8;
        f32x4 acc[NT][4];
#pragma unroll
        for (int t = 0; t < NT; ++t)
#pragma unroll
            for (int m = 0; m < 4; ++m) acc[t][m] = (f32x4){0.f, 0.f, 0.f, 0.f};
#pragma unroll 4
        for (int st = 0; st < steps; ++st) {
            bf16x8 af[4], bfr[NT];
#pragma unroll
            for (int m = 0; m < 4; ++m) af[m] = *(const bf16x8*)(ap + (long)m * 16 * lda + st * 32);
#pragma unroll
            for (int t = 0; t < NT; ++t) bfr[t] = *(const bf16x8*)(bp + (long)t * 128 * ldb + st * 32);
#pragma unroll
            for (int t = 0; t < NT; ++t)
#pragma unroll
                for (int m = 0; m < 4; ++m) acc[t][m] = __builtin_amdgcn_mfma_f32_16x16x32_bf16(af[m], bfr[t], acc[t][m], 0, 0, 0);
        }
        __syncthreads();
#pragma unroll
        for (int t = 0; t < NT; ++t)
#pragma unroll
            for (int m = 0; m < 4; ++m)
#pragma unroll
                for (int jj = 0; jj < 4; ++jj) red[((wid * NT + t) * 4 + m) * 256 + (4 * fq + jj) * 16 + fr] = acc[t][m][jj];
        __syncthreads();
        { const int e = tid * 2, row = e >> 4, col = e & 15; float v[2][2];
#pragma unroll
          for (int t = 0; t < 2; ++t) { v[t][0] = 0.f; v[t][1] = 0.f;
              if (t < NT) {
#pragma unroll
                  for (int w = 0; w < 8; ++w) { const float* rp = red + ((w * NT + t) * 4 + (row >> 4)) * 256 + (row & 15) * 16 + col; v[t][0] += rp[0]; v[t][1] += rp[1]; } } }
          E(rb * 64 + row, cgi * 16 + col, v); }
    }
    __syncthreads();
}

__device__ __forceinline__ void rows_phase(const float* xsrc, const float* f, const float* gpost, float w, const float* gpre, float* xdst, bf16_t* h, int r0, int r1) {
    const int tid = opaque_tid(); const int lane = tid & 63, gw = blockIdx.x * 8 + (tid >> 6), nw = gridDim.x * 8;
    for (int r = r0 + gw; r < r1; r += nw) {
        f32x4 xv[4];
#pragma unroll
        for (int k = 0; k < 4; ++k) xv[k] = *(const f32x4*)(xsrc + (long)r * D + k * 256 + lane * 4);
        if (f) {
            f32x4 fv[4]; float ss = 0.f;
#pragma unroll
            for (int k = 0; k < 4; ++k) { fv[k] = *(const f32x4*)(f + (long)r * D + k * 256 + lane * 4); ss += fv[k][0] * fv[k][0] + fv[k][1] * fv[k][1] + fv[k][2] * fv[k][2] + fv[k][3] * fv[k][3]; }
            ss = wave_sum(ss, lane);
            const float rs = w * rsqrtf(ss * (1.0f / D) + EPS);
#pragma unroll
            for (int k = 0; k < 4; ++k) { const f32x4 gp = *(const f32x4*)(gpost + k * 256 + lane * 4); xv[k] = xv[k] + fv[k] * gp * rs; }
        }
        if (xdst) {
#pragma unroll
            for (int k = 0; k < 4; ++k) *(f32x4*)(xdst + (long)r * D + k * 256 + lane * 4) = xv[k];
        }
        if (h) {
            float ss = 0.f;
#pragma unroll
            for (int k = 0; k < 4; ++k) ss += xv[k][0] * xv[k][0] + xv[k][1] * xv[k][1] + xv[k][2] * xv[k][2] + xv[k][3] * xv[k][3];
            ss = wave_sum(ss, lane);
            const float rs = rsqrtf(ss * (1.0f / D) + EPS);
#pragma unroll
            for (int k = 0; k < 4; ++k) { const f32x4 gp = *(const f32x4*)(gpre + k * 256 + lane * 4); const f32x4 o = xv[k] * gp * rs;
                u32x2 wv; wv.x = cvt_pk_bf16(o[0], o[1]); wv.y = cvt_pk_bf16(o[2], o[3]); *(u32x2*)(h + (long)r * D + k * 256 + lane * 4) = wv; }
        }
    }
}

__device__ __forceinline__ void tconv_phase(const Params& p, unsigned char* shm) {
    bf16_t* tile = (bf16_t*)shm;
    const int tid = opaque_tid();
    for (int T = blockIdx.x; T < p.ntiles; T += gridDim.x) {
        int j = 0;
#pragma unroll 1
        for (int q = 1; q < NJOBS; ++q) if (T >= p.jobs[q].tile0) j = q;
        const TJob jb = p.jobs[j];
        int t = T - jb.tile0; const int per = jb.tr * jb.tc; const int b = t / per; t -= b * per; const int tr = t / jb.tc, tc = t % jb.tc;
        const float* src = jb.src + (long)b * jb.sbs; bf16_t* dst = jb.dst + (long)b * jb.dbs;
        const int R0 = tr * 64, C0 = tc * 64;
        { const int r = tid >> 3, c8 = (tid & 7) * 8;
          const f32x4 v0 = *(const f32x4*)(src + (long)(R0 + r) * jb.lds + C0 + c8), v1 = *(const f32x4*)(src + (long)(R0 + r) * jb.lds + C0 + c8 + 4);
          if (jb.mode == 3) { u32x4 w; w.x = cvt_pk_bf16(v0[0], v0[1]); w.y = cvt_pk_bf16(v0[2], v0[3]); w.z = cvt_pk_bf16(v1[0], v1[1]); w.w = cvt_pk_bf16(v1[2], v1[3]);
              *(u32x4*)(dst + (long)(R0 + r) * jb.ldd + C0 + c8) = w; continue; }
          const unsigned a0 = cvt_pk_bf16(v0[0], v0[1]), a1 = cvt_pk_bf16(v0[2], v0[3]), a2 = cvt_pk_bf16(v1[0], v1[1]), a3 = cvt_pk_bf16(v1[2], v1[3]);
          tile[(c8 + 0) * 72 + r] = (bf16_t)(a0 & 0xffff); tile[(c8 + 1) * 72 + r] = (bf16_t)(a0 >> 16);
          tile[(c8 + 2) * 72 + r] = (bf16_t)(a1 & 0xffff); tile[(c8 + 3) * 72 + r] = (bf16_t)(a1 >> 16);
          tile[(c8 + 4) * 72 + r] = (bf16_t)(a2 & 0xffff); tile[(c8 + 5) * 72 + r] = (bf16_t)(a2 >> 16);
          tile[(c8 + 6) * 72 + r] = (bf16_t)(a3 & 0xffff); tile[(c8 + 7) * 72 + r] = (bf16_t)(a3 >> 16); }
        __syncthreads();
        { const int c = tid >> 3, r8 = (tid & 7) * 8; const int cc = C0 + c;
          int drow = cc; if (jb.mode == 1) drow = (cc >> 7) * 256 + (cc & 127); else if (jb.mode == 2) drow = (cc >> 7) * 256 + 128 + (cc & 127);
          const u32x4 w = *(const u32x4*)(tile + c * 72 + r8);
          *(u32x4*)(dst + (long)drow * jb.ldd + R0 + r8) = w; }
        __syncthreads();
    }
}

__device__ __forceinline__ void lam_pow(const Params& p, int j, int g, int pp, int n, float& re, float& im) {
    const double dt = exp((double)p.in[26][j * 64 + g]);
    const long gp = ((long)j * 64 + g) * 64 + pp;
    const double lr = (double)p.in[19][gp] * dt * n, li = (double)p.in[20][gp] * dt * n;
    const double red = li - 6.283185307179586476925 * rint(li * 0.15915494309189533577);
    const float mg = (float)exp(lr); float sn, cs; sincosf((float)red, &sn, &cs); re = mg * cs; im = mg * sn;
}
__device__ __forceinline__ void s5prep_phase(const Params& p, unsigned char* shm) {
    float* lamr = (float*)shm;
    float* lami = lamr + 17 * 64;
    float* Bbr = lami + 17 * 64;
    float* Bbi = Bbr + 1024;
    float* Ccr = Bbi + 1024;
    float* Cci = Ccr + 1024;
    float* Kt = Cci + 1024;
    const int tid = opaque_tid();
    bf16_t* TV = (bf16_t*)(p.ws + O_TV); bf16_t* W5 = (bf16_t*)(p.ws + O_W5);
    for (int job = blockIdx.x; job < 128; job += gridDim.x) {
        const int j = job >> 6, g = job & 63;
        __syncthreads();
        if (tid < 64) {
            const int pp = tid; const long gp = ((long)j * 64 + g) * 64 + pp;
            const float dt = expf(p.in[26][j * 64 + g]);
            const float are = p.in[19][gp], aim = p.in[20][gp];
            const float lr = are * dt, li = aim * dt;
            for (int t = 0; t <= 16; ++t) { const float mg = expf(lr * t); float sn, cs; sincosf(li * t, &sn, &cs); lamr[t * 64 + pp] = mg * cs; lami[t * 64 + pp] = mg * sn; }
            const float nr = lamr[64 + pp] - 1.0f, ni = lami[64 + pp]; const float den = are * are + aim * aim;
            const float cr = (nr * are + ni * aim) / den, ci = (ni * are - nr * aim) / den;
            for (int c = 0; c < 16; ++c) { const float br = p.in[21][gp * 16 + c], bi = p.in[22][gp * 16 + c];
                Bbr[pp * 16 + c] = cr * br - ci * bi; Bbi[pp * 16 + c] = cr * bi + ci * br; }
            float q0, q1, q2, q3; lam_pow(p, j, g, pp, 16, q0, q1); lam_pow(p, j, g, pp, 1024, q2, q3);
            *(f32x4*)((float*)(p.ws + O_LAM) + gp * 4) = (f32x4){q0, q1, q2, q3};
        }
        for (int e = tid; e < 1024; e += 512) { const long gi = ((long)j * 64 + g) * 1024 + e; Ccr[e] = p.in[23][gi]; Cci[e] = p.in[24][gi]; }
        __syncthreads();
        for (int o = tid; o < 4096; o += 512) { const int tau = o >> 8, c = (o >> 4) & 15, cp = o & 15; float s = 0.f;
            for (int pp = 0; pp < 64; ++pp) { const float clr = Ccr[c * 64 + pp] * lamr[tau * 64 + pp] - Cci[c * 64 + pp] * lami[tau * 64 + pp];
                const float cli = Ccr[c * 64 + pp] * lami[tau * 64 + pp] + Cci[c * 64 + pp] * lamr[tau * 64 + pp];
                s += clr * Bbr[pp * 16 + cp] - cli * Bbi[pp * 16 + cp]; }
            Kt[o] = s; }
        __syncthreads();
        bf16_t* tv = TV + ((long)j * 64 + g) * 256 * UK;
        for (int e = tid; e < 256 * (UK / 2); e += 512) { const int n = e / (UK / 2), k = (e % (UK / 2)) * 2; const int jj = n >> 4, c = n & 15; float v[2];
#pragma unroll
            for (int q = 0; q < 2; ++q) { const int kk = k + q;
                if (kk < 256) { const int i = kk >> 4, cp = kk & 15; v[q] = (i <= jj) ? Kt[(jj - i) * 256 + c * 16 + cp] : 0.f; }
                else if (kk < 320) { const int pp = kk - 256; v[q] = Ccr[c * 64 + pp] * lamr[(jj + 1) * 64 + pp] - Cci[c * 64 + pp] * lami[(jj + 1) * 64 + pp]; }
                else { const int pp = kk - 320; v[q] = -(Ccr[c * 64 + pp] * lami[(jj + 1) * 64 + pp] + Cci[c * 64 + pp] * lamr[(jj + 1) * 64 + pp]); } }
            *(unsigned*)(tv + (long)n * UK + k) = cvt_pk_bf16(v[0], v[1]); }
        bf16_t* w5 = W5 + ((long)j * 64 + g) * 128 * 256;
        for (int e = tid; e < 128 * 128; e += 512) { const int n = e >> 7, k = (e & 127) * 2; const int pp = n & 63; const bool im = n >= 64; float v[2];
#pragma unroll
            for (int q = 0; q < 2; ++q) { const int kk = k + q, i = kk >> 4, cp = kk & 15; const int t = 15 - i;
                const float re = lamr[t * 64 + pp] * Bbr[pp * 16 + cp] - lami[t * 64 + pp] * Bbi[pp * 16 + cp];
                const float ii = lamr[t * 64 + pp] * Bbi[pp * 16 + cp] + lami[t * 64 + pp] * Bbr[pp * 16 + cp];
                v[q] = im ? ii : re; }
            *(unsigned*)(w5 + (long)n * 256 + k) = cvt_pk_bf16(v[0], v[1]); }
    }
    __syncthreads();
}

__device__ __forceinline__ void scan_phase(const Params& p, int j, unsigned char* shm) {
    float* E = (float*)shm;
    const int tid = opaque_tid();
    const float* S = (const float*)(p.ws + O_S); bf16_t* U = (bf16_t*)(p.ws + O_U);
    for (int item = blockIdx.x; item < 128; item += gridDim.x) {
        const int seq = item >> 6, g = item & 63, pp = tid & 63, sc = tid >> 6;
        const f32x4 lq = *(const f32x4*)((const float*)(p.ws + O_LAM) + (((long)j * 64 + g) * 64 + pp) * 4); const float ar = lq[0], ai = lq[1], br = lq[2], bi = lq[3];
        const int row0 = seq * 512 + sc * 64;
        const float* Sg = S + ((long)g * CR + row0) * 128 + pp;
        float er = 0.f, ei = 0.f;
#pragma unroll 8
        for (int k = 0; k < 64; ++k) { const float sr = Sg[k * 128], si = Sg[k * 128 + 64]; const float nr = ar * er - ai * ei + sr, ni = ar * ei + ai * er + si; er = nr; ei = ni; }
        __syncthreads();
        E[(sc * 64 + pp) * 2] = er; E[(sc * 64 + pp) * 2 + 1] = ei;
        __syncthreads();
        float hr = 0.f, hi = 0.f;
        for (int m = 0; m < sc; ++m) { const float xr = E[(m * 64 + pp) * 2], xi = E[(m * 64 + pp) * 2 + 1]; const float nr = br * hr - bi * hi + xr, ni = br * hi + bi * hr + xi; hr = nr; hi = ni; }
        bf16_t* Ug = U + (long)g * USTRIDE + (long)row0 * UK + 256 + pp;
#pragma unroll 8
        for (int k = 0; k < 64; ++k) { const float sr = Sg[k * 128], si = Sg[k * 128 + 64];
            Ug[k * UK] = (bf16_t)(cvt_pk_bf16(hr, 0.f) & 0xffff); Ug[k * UK + 64] = (bf16_t)(cvt_pk_bf16(hi, 0.f) & 0xffff);
            const float nr = ar * hr - ai * hi + sr, ni = ar * hi + ai * hr + si; hr = nr; hi = ni; }
        if (sc == 7) { const long o = (((long)j * 2 + seq) * 64 + g) * 64 + pp; p.out[OO_SRP + o] = hr; p.out[OO_SIP + o] = hi; }
    }
    { const int lane = tid & 63, gw = blockIdx.x * 8 + (tid >> 6), nw = gridDim.x * 8;
      for (int item = gw; item < 512; item += nw) { const int s = item >> 6, g = item & 63, pp = lane;
          const f32x4 lq = *(const f32x4*)((const float*)(p.ws + O_LAM) + (((long)j * 64 + g) * 64 + pp) * 4); const float ar = lq[0], ai = lq[1];
          const long si = (((long)j * 8 + s) * 64 + g) * 64 + pp;
          float hr = p.in[4][si], hi = p.in[5][si];
          const int row0 = 1024 + 2 * s;
          const float* Sg = S + ((long)g * CR + row0) * 128 + pp;
          bf16_t* Ug = U + (long)g * USTRIDE + (long)row0 * UK + 256 + pp;
#pragma unroll
          for (int k = 0; k < 2; ++k) { const float sr = Sg[k * 128], sim = Sg[k * 128 + 64];
              Ug[k * UK] = (bf16_t)(cvt_pk_bf16(hr, 0.f) & 0xffff); Ug[k * UK + 64] = (bf16_t)(cvt_pk_bf16(hi, 0.f) & 0xffff);
              const float nr = ar * hr - ai * hi + sr, ni = ar * hi + ai * hr + sim; hr = nr; hi = ni; }
          p.out[OO_SRS + si] = hr; p.out[OO_SIS + si] = hi; } }
}

__device__ __forceinline__ f32x4 pool_row(const float* F, const float* hist, int base, int t, int col) {
    if (t >= 0) return *(const f32x4*)(F + (long)(base + t) * D + col);
    if (hist) return *(const f32x4*)(hist + (long)(15 + t) * D + col);
    return (f32x4){0.f, 0.f, 0.f, 0.f};
}
__device__ __forceinline__ void pool_phase(const Params& p, int j) {
    const float* F = (const float*)(p.ws + O_F); bf16_t* Z = (bf16_t*)(p.ws + O_Z);
    const int tid = opaque_tid(); const int lane = tid & 63, gw = blockIdx.x * 8 + (tid >> 6), nw = gridDim.x * 8;
    for (int item = gw; item < 520 * 4; item += nw) {
        const int seg = item >> 2, grp = item & 3; const int W = 2 << grp; const int col = grp * 256 + lane * 4;
        const int tok0 = seg * 32;
        int base, t0, pos0; const float* hist = nullptr;
        if (tok0 < TP) { base = (tok0 >> 13) << 13; t0 = tok0 - base; pos0 = 0; }
        else { const int s = (tok0 - TP) >> 5; base = tok0; t0 = 0; pos0 = 1024; hist = p.in[6] + ((long)j * 8 + s) * 15 * D; }
        f32x4 sum = (f32x4){0.f, 0.f, 0.f, 0.f};
        for (int k = 1; k < W; ++k) sum = sum + pool_row(F, hist, base, t0 - k, col);
        for (int i = 0; i < 32; ++i) { const int t = t0 + i; const f32x4 u = *(const f32x4*)(F + (long)(base + t) * D + col);
            sum = sum + u;
            const int cnt = min(pos0 + t + 1, W); const float inv = 1.0f / (float)cnt;
            const f32x4 o = sum * inv - u;
            u32x2 wv; wv.x = cvt_pk_bf16(o[0], o[1]); wv.y = cvt_pk_bf16(o[2], o[3]); *(u32x2*)(Z + (long)(base + t) * D + col) = wv;
            sum = sum - pool_row(F, hist, base, t - W + 1, col); }
    }
    for (int e = blockIdx.x * 512 + tid; e < 10 * 15 * 256; e += gridDim.x * 512) {
        const int c4 = (e & 255) * 4, r = (e >> 8) % 15, sq = (e >> 8) / 15;
        if (sq < 2) { const f32x4 v = *(const f32x4*)(F + (long)(sq * 8192 + 8177 + r) * D + c4); *(f32x4*)(p.out + OO_PP + (((long)j * 2 + sq) * 15 + r) * D + c4) = v; }
        else { const int s = sq - 2; const f32x4 v = *(const f32x4*)(F + (long)(TP + s * 32 + 17 + r) * D + c4); *(f32x4*)(p.out + OO_PS + (((long)j * 8 + s) * 15 + r) * D + c4) = v; }
    }
}

__device__ __forceinline__ void sample_attn_phase(const Params& p, int l, unsigned char* shm) {
    float* Ssm = (float*)shm;
    const int tid = opaque_tid(), wid = tid >> 6, lane = tid & 63, fr = lane & 15, fq = lane >> 4;
    const bf16_t* Q = (const bf16_t*)(p.ws + O_Z) + (long)TP * D; bf16_t* Oo = (bf16_t*)(p.ws + O_H) + (long)TP * D;
    for (int item = blockIdx.x; item < 32; item += gridDim.x) {
        const int b = item >> 2, h = item & 3;
        const float* Kc = p.in[2] + (((long)l * 8 + b) * 256) * D + h * 256;
        const float* Vc = p.in[3] + (((long)l * 8 + b) * 256) * D + h * 256;
        f32x4 acc[2][2];
#pragma unroll
        for (int a = 0; a < 2; ++a)
#pragma unroll
            for (int n = 0; n < 2; ++n) acc[a][n] = (f32x4){0.f, 0.f, 0.f, 0.f};
        for (int st = 0; st < 8; ++st) {
            bf16x8 af[2], bfr[2];
#pragma unroll
            for (int a = 0; a < 2; ++a) af[a] = *(const bf16x8*)(Q + (long)(b * 32 + a * 16 + fr) * D + h * 256 + st * 32 + fq * 8);
#pragma unroll
            for (int n = 0; n < 2; ++n) { const float* kp = Kc + (long)(wid * 32 + n * 16 + fr) * D + st * 32 + fq * 8;
                const f32x4 k0 = *(const f32x4*)kp, k1 = *(const f32x4*)(kp + 4);
                u32x4 w; w.x = cvt_pk_bf16(k0[0], k0[1]); w.y = cvt_pk_bf16(k0[2], k0[3]); w.z = cvt_pk_bf16(k1[0], k1[1]); w.w = cvt_pk_bf16(k1[2], k1[3]);
                bfr[n] = __builtin_bit_cast(bf16x8, w); }
#pragma unroll
            for (int a = 0; a < 2; ++a)
#pragma unroll
                for (int n = 0; n < 2; ++n) acc[a][n] = __builtin_amdgcn_mfma_f32_16x16x32_bf16(af[a], bfr[n], acc[a][n], 0, 0, 0);
        }
        __syncthreads();
#pragma unroll
        for (int a = 0; a < 2; ++a)
#pragma unroll
            for (int n = 0; n < 2; ++n)
#pragma unroll
                for (int jj = 0; jj < 4; ++jj) Ssm[(a * 16 + 4 * fq + jj) * 256 + wid * 32 + n * 16 + fr] = acc[a][n][jj] * 0.0625f;
        __syncthreads();
        for (int rr = 0; rr < 4; ++rr) { const int r = wid * 4 + rr; f32x4 v = *(const f32x4*)(Ssm + r * 256 + lane * 4);
            const float mxv = wave_max(fmaxf(fmaxf(v[0], v[1]), fmaxf(v[2], v[3])), lane);
            v[0] = __expf(v[0] - mxv); v[1] = __expf(v[1] - mxv); v[2] = __expf(v[2] - mxv); v[3] = __expf(v[3] - mxv);
            const float inv = 1.0f / wave_sum(v[0] + v[1] + v[2] + v[3], lane);
            *(f32x4*)(Ssm + r * 256 + lane * 4) = v * inv; }
        __syncthreads();
        { const int d = tid & 255, qh = tid >> 8; float o[16];
#pragma unroll
          for (int q = 0; q < 16; ++q) o[q] = 0.f;
          for (int m = 0; m < 256; m += 4) { const float v0 = Vc[(long)m * D + d], v1 = Vc[(long)(m + 1) * D + d], v2 = Vc[(long)(m + 2) * D + d], v3 = Vc[(long)(m + 3) * D + d];
#pragma unroll
              for (int q = 0; q < 16; ++q) { const f32x4 pv = *(const f32x4*)(Ssm + (qh * 16 + q) * 256 + m); o[q] += pv[0] * v0 + pv[1] * v1 + pv[2] * v2 + pv[3] * v3; } }
#pragma unroll
          for (int q = 0; q < 16; ++q) Oo[(long)(b * 32 + qh * 16 + q) * D + h * 256 + d] = (bf16_t)(cvt_pk_bf16(o[q], 0.f) & 0xffff); }
        __syncthreads();
    }
}

__global__ void __launch_bounds__(512, 2) mega(const Params p) {
    extern __shared__ __attribute__((aligned(16))) unsigned char shm[];
    cg::grid_group grid = cg::this_grid();
    LAS unsigned char* lds = (LAS unsigned char*)shm;
#define ws (opq_ptr(p.ws))
#define X ((float*)opq_ptr((unsigned char*)p.out))
#define H ((bf16_t*)(ws + O_H))
#define Z ((bf16_t*)(ws + O_Z))
#define F ((float*)(ws + O_F))
#define ACT ((bf16_t*)(ws + O_ACT))
#define U ((bf16_t*)(ws + O_U))
#define S ((float*)(ws + O_S))
#define npre ((const float*)opq_ptr((unsigned char*)p.in[8]))
#define npost ((const float*)opq_ptr((unsigned char*)p.in[9]))

    volatile LAS unsigned* xst = (volatile LAS unsigned*)(lds + LDS_ST);
    if (threadIdx.x == 0) { xst[0] = 0u; xst[1] = 0u; }
    __syncthreads();
    const XcdBarrier xb = xcd_barrier_post((unsigned*)(ws + O_BAR), xst);
    tconv_phase(p, shm);
    s5prep_phase(p, shm);
#pragma unroll 1
    for (int l = 0; l < 4; ++l) rows_phase(p.in[7], nullptr, nullptr, 0.f, p.in[10] + l * D, nullptr, (bf16_t*)(ws + O_AMEM) + (long)l * 512 * D, 0, 512);
    rows_phase(p.in[0], nullptr, nullptr, 0.f, npre, X, H, 0, TP);
    rows_phase(p.in[1] - (long)TP * D, nullptr, nullptr, 0.f, npre, X, H, TP, TT);
    grid.sync();
    { GD g = gd_zero(); g.A = (const bf16_t*)(ws + O_AMEM); g.B = (const bf16_t*)(ws + O_WKT); g.lda = D; g.ldb = D; g.nt = 16; g.n = 64; g.d0 = 2; g.d1 = 4; g.d2 = 4;
      g.sa[0] = (int)(256L * D); g.sa[2] = (int)(512L * D); g.sb[1] = (int)(256L * D); g.sb[2] = (int)(M1); g.sb[3] = (int)(4 * M1);
      g.sc[0] = (int)(256L * D); g.sc[1] = (int)(256); g.sc[2] = (int)(512L * D); g.sc[3] = (int)(2097152L);
      EpiF32Bf16 e; e.C = p.out + OO_MEMK; e.O = (bf16_t*)(ws + O_KBF); e.ldc = D;
      gemm_run(lds, g, e, 0); }
    xcd_barrier(xb);
    { GD g = gd_zero(); g.A = (const bf16_t*)(ws + O_KBF); g.B = (const bf16_t*)(ws + O_WQP); g.lda = D; g.ldb = D; g.nt = 4; g.n = 128; g.d0 = 4; g.d1 = 4; g.d2 = 2;
      g.sa[1] = (int)(256); g.sa[2] = (int)(256L * D); g.sa[3] = (int)(512L * D); g.sb[0] = (int)(256L * D); g.sb[1] = (int)(256); g.sb[3] = (int)(M1);
      g.sc[0] = (int)(256); g.sc[1] = (int)(256L * D); g.sc[2] = (int)(M1); g.sc[3] = (int)(2 * M1);
      EpiBf16 e; e.O = (bf16_t*)(ws + O_QK); e.ldc = D; e.s = 0.0625f;
      gemm_run(lds, g, e, 0); }
    { GD g = gd_zero(); g.A = (const bf16_t*)(ws + O_WOT); g.B = (const bf16_t*)(ws + O_KBF) + 2097152L; g.lda = D; g.ldb = D; g.nt = 4; g.n = 128; g.d0 = 4; g.d1 = 4; g.d2 = 2;
      g.sa[0] = (int)(256L * D); g.sa[1] = (int)(256); g.sa[3] = (int)(M1); g.sb[1] = (int)(256); g.sb[2] = (int)(256L * D); g.sb[3] = (int)(512L * D);
      g.sc[0] = (int)(256L * D); g.sc[1] = (int)(256); g.sc[2] = (int)(M1); g.sc[3] = (int)(2 * M1);
      EpiBf16 e; e.O = (bf16_t*)(ws + O_VW); e.ldc = D; e.s = 1.0f;
      gemm_run(lds, g, e, 128); }
    xcd_barrier(xb);

#pragma unroll 1
    for (int l = 0; l < 4; ++l) {
        const int j = l >> 1;
#pragma unroll 1
        for (int sub = 0; sub < 4; ++sub) {
            if (sub == 0 || sub == 3) {
                const int s = sub ? 1 : 0;
                { GD g = gd_plain(H, D, (const bf16_t*)(ws + O_WGU) + (long)(l * 2 + s) * 5632 * D, D, D, 64, 22, DFF, 128);
                  EpiSwiGLU e; e.O = ACT; e.ldc = DFF; gemm_run(lds, g, e, 0); }
                { SkSwiGLU e; e.O = ACT + (long)TP * DFF; e.ldc = DFF;
                  skinny<2>(shm, H + (long)TP * D, D, (const bf16_t*)(ws + O_WGU) + (long)(l * 2 + s) * 5632 * D, D, D, 176, true, 1 << 20, e, 128, 128); }
                xcd_barrier(xb);
                { SkF32 e; e.C = F + (long)TP * D; e.ldc = D; e.bias = nullptr; e.scale = nullptr;
                  skinny<1>(shm, ACT + (long)TP * DFF, DFF, (const bf16_t*)(ws + O_WDN) + (long)(l * 2 + s) * D * DFF, DFF, DFF, 64, false, 1 << 20, e, 0, 256); }
                { GD g = gd_plain(ACT, DFF, (const bf16_t*)(ws + O_WDN) + (long)(l * 2 + s) * D * DFF, DFF, DFF, 64, 4, D, 256);
                  EpiF32 e; e.C = F; e.ldc = D; e.bias = nullptr; e.scale = nullptr; gemm_run(lds, g, e, 0); }
                xcd_barrier(xb);
                const bool lastsub = (l == 3 && sub == 3);
                rows_phase(X, F, npost + (l * 4 + sub) * D, 0.5f, lastsub ? nullptr : npre + (sub == 0 ? (l * 4 + 1) : ((l + 1) * 4)) * D, X, lastsub ? nullptr : H, 0, TT);
                xcd_barrier(xb);
            } else if (sub == 1) {
                if ((l & 1) == 0) {
                    { SkS5U e; e.Ub = U;
                      skinny<1>(shm, H + (long)TP * D, D, (const bf16_t*)(ws + O_WSI) + (long)j * M1, D, D, 64, false, 1 << 20, e, 0, 256); }
                    { GD g = gd_plain(H, D, (const bf16_t*)(ws + O_WSI) + (long)j * M1, D, D, 64, 4, D, 256);
                      EpiS5U e; e.Ub = U; gemm_run(lds, g, e, 0); }
                    xcd_barrier(xb);
                    { GD g = gd_zero(); g.A = U; g.B = (const bf16_t*)(ws + O_W5) + (long)j * 64 * 128 * 256; g.lda = UK; g.ldb = 256; g.nt = 4; g.n = 320; g.d0 = 5; g.d1 = 64; g.d2 = 1;
                      g.sa[0] = (int)(256L * UK); g.sa[1] = (int)(USTRIDE); g.sb[1] = (int)(128L * 256);
                      EpiS5S e; e.Sb = S; gemm_run(lds, g, e, 0); }
                    xcd_barrier(xb);
                    scan_phase(p, j, shm);
                    xcd_barrier(xb);
                    { GD g = gd_zero(); g.A = U; g.B = (const bf16_t*)(ws + O_TV) + (long)j * 64 * 256 * UK; g.lda = UK; g.ldb = UK; g.nt = 6; g.n = 320; g.d0 = 5; g.d1 = 64; g.d2 = 1;
                      g.sa[0] = (int)(256L * UK); g.sa[1] = (int)(USTRIDE); g.sb[1] = (int)(256L * UK);
                      EpiS5D e; e.Ub = U; e.dvec = p.in[25] + j * D; e.Zb = Z; gemm_run(lds, g, e, 0); }
                    xcd_barrier(xb);
                    { SkGLU e; e.C = F + (long)TP * D; e.ldc = D;
                      skinny<2>(shm, Z + (long)TP * D, D, (const bf16_t*)(ws + O_WGL) + (long)j * 2048 * D, D, D, 64, true, 1 << 20, e, 0, 256); }
                    { GD g = gd_plain(Z, D, (const bf16_t*)(ws + O_WGL) + (long)j * 2048 * D, D, D, 64, 8, D, 128);
                      EpiGLU e; e.C = F; e.ldc = D; gemm_run(lds, g, e, 0); }
                    xcd_barrier(xb);
                } else {
                    { SkF32 e; e.C = F + (long)TP * D; e.ldc = D; e.bias = nullptr; e.scale = nullptr;
                      skinny<1>(shm, H + (long)TP * D, D, (const bf16_t*)(ws + O_WPI) + (long)j * M1, D, D, 64, false, 1 << 20, e, 0, 256); }
                    { GD g = gd_plain(H, D, (const bf16_t*)(ws + O_WPI) + (long)j * M1, D, D, 64, 4, D, 256);
                      EpiF32 e; e.C = F; e.ldc = D; e.bias = nullptr; e.scale = nullptr; gemm_run(lds, g, e, 0); }
                    xcd_barrier(xb);
                    pool_phase(p, j);
                    xcd_barrier(xb);
                    { GD g = gd_zero(); g.A = Z; g.B = (const bf16_t*)(ws + O_WGR) + (long)j * 4 * 65536; g.lda = D; g.ldb = 256; g.nt = 4; g.n = 256; g.d0 = 64; g.d1 = 4; g.d2 = 1;
                      g.sa[0] = (int)(256L * D); g.sa[1] = (int)(256); g.sb[1] = (int)(65536); g.sc[0] = (int)(256L * D); g.sc[1] = (int)(256);
                      EpiF32 e; e.C = F; e.ldc = D; e.bias = p.in[30] + j * D; e.scale = p.in[31] + j * D; gemm_run(lds, g, e, 0); }
                    { SkF32 e; e.C = F + (long)TP * D; e.ldc = D; e.bias = p.in[30] + j * D; e.scale = p.in[31] + j * D;
                      skinny<1>(shm, Z + (long)TP * D, D, (const bf16_t*)(ws + O_WGR) + (long)j * 4 * 65536, 256, 256, 64, false, 16, e, 0, 256); }
                    xcd_barrier(xb);
                }
                rows_phase(X, F, npost + (l * 4 + 1) * D, 1.0f, npre + (l * 4 + 2) * D, X, H, 0, TT);
                xcd_barrier(xb);
            } else {
                { GD g = gd_zero(); g.A = H; g.B = (const bf16_t*)(ws + O_QK) + (long)l * 2 * M1; g.lda = D; g.ldb = D; g.nt = 16; g.n = 256; g.d0 = 32; g.d1 = 2; g.d2 = 4;
                  g.sa[0] = (int)(256L * D); g.sa[1] = (int)(32L * 256 * D); g.sb[1] = (int)(M1); g.sb[2] = (int)(256L * D); g.sc[0] = (int)(256L * D); g.sc[1] = (int)(32L * 256 * D); g.sc[2] = (int)(256);
                  EpiSoftmax e; e.O = Z; e.ldc = D; e.Xl = (LAS float*)(lds + LDS_X); gemm_run(lds, g, e, 0); }
                { SkBf16 e; e.O = Z + (long)TP * D; e.ldc = D;
                  skinny<1>(shm, H + (long)TP * D, D, (const bf16_t*)(ws + O_WQT) + (long)l * M1, D, D, 64, false, 1 << 20, e, 0, 256); }
                xcd_barrier(xb);
                { GD g = gd_zero(); g.A = Z; g.B = (const bf16_t*)(ws + O_VW) + (long)l * 2 * M1; g.lda = D; g.ldb = D; g.nt = 16; g.n = 256; g.d0 = 32; g.d1 = 2; g.d2 = 4;
                  g.sa[0] = (int)(256L * D); g.sa[1] = (int)(32L * 256 * D); g.sb[1] = (int)(M1); g.sb[2] = (int)(256L * D); g.sc[0] = (int)(256L * D); g.sc[1] = (int)(32L * 256 * D); g.sc[2] = (int)(256);
                  EpiF32 e; e.C = F; e.ldc = D; e.bias = nullptr; e.scale = nullptr; gemm_run(lds, g, e, 0); }
                sample_attn_phase(p, l, shm);
                xcd_barrier(xb);
                { SkF32 e; e.C = F + (long)TP * D; e.ldc = D; e.bias = nullptr; e.scale = nullptr;
                  skinny<1>(shm, H + (long)TP * D, D, (const bf16_t*)(ws + O_WOT) + (long)l * M1, D, D, 64, false, 1 << 20, e, 0, 256); }
                xcd_barrier(xb);
                rows_phase(X, F, npost + (l * 4 + 2) * D, 1.0f, npre + (l * 4 + 3) * D, X, H, 0, TT);
                xcd_barrier(xb);
            }
        }
    }
}
#undef ws
#undef X
#undef H
#undef Z
#undef F
#undef ACT
#undef U
#undef S
#undef npre
#undef npost

static void add_job(Params& p, int& nj, int& tiles, const float* src, bf16_t* dst, int R, int C, int lds, int ldd, int mode, int nb, long sbs, long dbs) {
    TJob& j = p.jobs[nj++]; j.src = src; j.dst = dst; j.sbs = sbs; j.dbs = dbs; j.lds = lds; j.ldd = ldd; j.tr = R / 64; j.tc = C / 64; j.mode = mode; j.nb = nb; j.tile0 = tiles; j.pad = 0;
    tiles += nb * j.tr * j.tc;
}

extern "C" void kernel_launch(void* const* d_in, const int* in_sizes, int n_in, void* d_out, int out_size, void* d_ws, size_t ws_size, hipStream_t stream) {
    static int grid_blocks = 0;
    if (grid_blocks == 0) {
        if (n_in != 32 || (long)out_size != OUT_TOTAL || ws_size < WS_END) {
            fprintf(stderr, "kernel_launch: unexpected shapes (n_in %d out %d ws %zu need %zu)\n", n_in, out_size, ws_size, (size_t)WS_END); grid_blocks = -1; return; }
        int dev = 0, cus = 0, per_cu = 0;
        hipGetDevice(&dev);
        hipDeviceGetAttribute(&cus, hipDeviceAttributeMultiprocessorCount, dev);
        if (hipFuncSetAttribute((const void*)mega, hipFuncAttributeMaxDynamicSharedMemorySize, LDS_BYTES) != hipSuccess) { fprintf(stderr, "kernel_launch: hipFuncSetAttribute failed\n"); grid_blocks = -1; return; }
        if (hipOccupancyMaxActiveBlocksPerMultiprocessor(&per_cu, (const void*)mega, 512, LDS_BYTES) != hipSuccess || per_cu < 1) { fprintf(stderr, "kernel_launch: occupancy query failed (%d)\n", per_cu); (void)hipGetLastError(); per_cu = 1; }
        grid_blocks = cus * per_cu;
    }
    if (grid_blocks < 0) return;
    Params p; memset(&p, 0, sizeof(p));
    for (int i = 0; i < 32; ++i) p.in[i] = (const float*)d_in[i];
    p.out = (float*)d_out; p.ws = (unsigned char*)d_ws;
    unsigned char* ws = (unsigned char*)d_ws;
    int nj = 0, tiles = 0;
    const long WF = 1024L * 2816;
    add_job(p, nj, tiles, p.in[11], (bf16_t*)(ws + O_WGU), 1024, 2816, 2816, 1024, 1, 8, WF, 5632L * 1024);
    add_job(p, nj, tiles, p.in[12], (bf16_t*)(ws + O_WGU), 1024, 2816, 2816, 1024, 2, 8, WF, 5632L * 1024);
    add_job(p, nj, tiles, p.in[13], (bf16_t*)(ws + O_WDN), 2816, 1024, 1024, 2816, 0, 8, WF, WF);
    add_job(p, nj, tiles, p.in[14], (bf16_t*)(ws + O_WQT), 1024, 1024, 1024, 1024, 0, 4, M1, M1);
    add_job(p, nj, tiles, p.in[14], (bf16_t*)(ws + O_WQP), 1024, 1024, 1024, 1024, 3, 4, M1, M1);
    add_job(p, nj, tiles, p.in[15], (bf16_t*)(ws + O_WKT), 1024, 1024, 1024, 1024, 0, 4, M1, M1);
    add_job(p, nj, tiles, p.in[16], (bf16_t*)(ws + O_WKT) + 4 * M1, 1024, 1024, 1024, 1024, 0, 4, M1, M1);
    add_job(p, nj, tiles, p.in[17], (bf16_t*)(ws + O_WOT), 1024, 1024, 1024, 1024, 0, 4, M1, M1);
    add_job(p, nj, tiles, p.in[18], (bf16_t*)(ws + O_WSI), 1024, 1024, 1024, 1024, 0, 2, M1, M1);
    add_job(p, nj, tiles, p.in[27], (bf16_t*)(ws + O_WGL), 1024, 1024, 2048, 1024, 1, 2, 2 * M1, 2 * M1);
    add_job(p, nj, tiles, p.in[27] + 1024, (bf16_t*)(ws + O_WGL), 1024, 1024, 2048, 1024, 2, 2, 2 * M1, 2 * M1);
    add_job(p, nj, tiles, p.in[28], (bf16_t*)(ws + O_WPI), 1024, 1024, 1024, 1024, 0, 2, M1, M1);
    add_job(p, nj, tiles, p.in[29], (bf16_t*)(ws + O_WGR), 256, 256, 256, 256, 0, 8, 65536, 65536);
    while (nj < NJOBS) { TJob& j = p.jobs[nj++]; j.tile0 = 0x7fffffff; j.tr = 1; j.tc = 1; j.nb = 0; }
    p.ntiles = tiles;
    if (hipMemsetAsync((unsigned char*)d_ws + O_BAR, 0, 4096 * 4, stream) != hipSuccess) { fprintf(stderr, "kernel_launch: memset failed\n"); return; }
    void* args[] = {(void*)&p};
    hipError_t e = hipLaunchCooperativeKernel((const void*)mega, dim3(grid_blocks), dim3(512), args, LDS_BYTES, stream);
    if (e != hipSuccess) fprintf(stderr, "cooperative launch failed: %s (grid %d)\n", hipGetErrorString(e), grid_blocks);
}
```

```cpp
#include <hip/hip_runtime.h>
#include <hip/hip_cooperative_groups.h>
#include <cstdio>
#include <cstring>
namespace cg = cooperative_groups;

#define LAS __attribute__((address_space(3)))
typedef unsigned short bf16_t;
typedef short bf16x8 __attribute__((ext_vector_type(8)));
typedef float f32x4 __attribute__((ext_vector_type(4)));
typedef unsigned u32x4 __attribute__((ext_vector_type(4)));
typedef unsigned u32x2 __attribute__((ext_vector_type(2)));

constexpr int D = 1024, DFF = 2816, TP = 16384, TT = 16640;
constexpr int CR = 1040, UK = 384;
constexpr long USTRIDE = (long)CR * UK;
constexpr float EPS = 1e-6f;
constexpr long M1 = 1024 * 1024;

constexpr size_t AL(size_t x) { return (x + 255) & ~(size_t)255; }
constexpr size_t O_WGU = 0;
constexpr size_t O_WDN = O_WGU + AL((size_t)8 * 5632 * 1024 * 2);
constexpr size_t O_WQT = O_WDN + AL((size_t)8 * 1024 * 2816 * 2);
constexpr size_t O_WOT = O_WQT + AL((size_t)4 * M1 * 2);
constexpr size_t O_WSI = O_WOT + AL((size_t)4 * M1 * 2);
constexpr size_t O_WPI = O_WSI + AL((size_t)2 * M1 * 2);
constexpr size_t O_WGL = O_WPI + AL((size_t)2 * M1 * 2);
constexpr size_t O_WGR = O_WGL + AL((size_t)2 * 2048 * 1024 * 2);
constexpr size_t O_TV  = O_WGR + AL((size_t)2 * 4 * 65536 * 2);
constexpr size_t O_W5  = O_TV + AL((size_t)2 * 64 * 256 * UK * 2);
constexpr size_t O_QK  = O_W5 + AL((size_t)2 * 64 * 128 * 256 * 2 + 128 * 256 * 2);
constexpr size_t O_VW  = O_QK + AL((size_t)8 * M1 * 2);
constexpr size_t O_LAM = O_VW + AL((size_t)8 * M1 * 2);
constexpr size_t O_BAR = O_LAM + AL((size_t)2 * 64 * 64 * 4 * 4);
constexpr size_t O_CNT = O_BAR + AL((size_t)4096 * 4);
constexpr size_t O_XS  = O_CNT + AL((size_t)64 * 64 * 64 * 4);
constexpr size_t O_H   = O_XS + AL((size_t)2 * 524288 + 2 * 131072);
constexpr size_t O_Z   = O_H + AL((size_t)TT * D * 2);
constexpr size_t O_F   = O_Z + AL((size_t)TT * D * 2);
constexpr size_t O_ACT = O_F + AL((size_t)TT * D * 4);
constexpr size_t WS_END = O_ACT + AL((size_t)TT * DFF * 2);
constexpr size_t O_U   = O_ACT;
constexpr size_t O_S   = O_U + AL((size_t)64 * USTRIDE * 2 + 256 * UK * 2);
static_assert(O_S + (size_t)64 * CR * 128 * 4 <= WS_END, "U/S alias overflow");
constexpr size_t O_WKT = O_F;
constexpr size_t O_WQP = O_WKT + (size_t)8 * M1 * 2;
constexpr size_t O_AMEM = O_WQP + (size_t)4 * M1 * 2;
constexpr size_t O_KBF = O_AMEM + (size_t)4 * 512 * 1024 * 2;
static_assert(O_KBF + (size_t)8 * 512 * 1024 * 2 <= O_ACT, "prep alias overflow");

constexpr long OO_MEMK = (long)TT * D;
constexpr long OO_SRP = OO_MEMK + 2 * 2097152L;
constexpr long OO_SIP = OO_SRP + 16384;
constexpr long OO_PP = OO_SIP + 16384;
constexpr long OO_SRS = OO_PP + 61440;
constexpr long OO_SIS = OO_SRS + 65536;
constexpr long OO_PS = OO_SIS + 65536;
constexpr long OUT_TOTAL = OO_PS + 245760;

struct TJob { const float* src; bf16_t* dst; long sbs, dbs; int lds, ldd, tr, tc, mode, nb, tile0, pad; };
constexpr int NJOBS = 14;
struct Params {
    const float* in[32];
    float* out;
    unsigned char* ws;
    TJob jobs[NJOBS];
    int ntiles, pad;
};

__device__ __forceinline__ unsigned char* opq_ptr(unsigned char* x) {
    unsigned lo = (unsigned)(unsigned long long)x, hi = (unsigned)((unsigned long long)x >> 32);
    asm volatile("" : "+v"(lo), "+v"(hi));
    lo = __builtin_amdgcn_readfirstlane(lo); hi = __builtin_amdgcn_readfirstlane(hi);
    return (unsigned char*)(((unsigned long long)hi << 32) | lo); }
__device__ __forceinline__ void lds_barrier() { asm volatile("s_waitcnt lgkmcnt(0)" ::: "memory"); __builtin_amdgcn_s_barrier(); asm volatile("" ::: "memory"); }
__device__ __forceinline__ int opaque_tid(int wv) {
    int lane; asm volatile("v_mbcnt_lo_u32_b32 %0, -1, 0\n\tv_mbcnt_hi_u32_b32 %0, -1, %0" : "=v"(lane)); return wv * 64 + lane; }
__device__ __forceinline__ unsigned cvt_pk_bf16(float lo, float hi) { unsigned r; asm volatile("v_cvt_pk_bf16_f32 %0, %1, %2" : "=v"(r) : "v"(lo), "v"(hi)); return r; }
__device__ __forceinline__ float bf2f(unsigned short b) { return __uint_as_float(((unsigned)b) << 16); }
__device__ __forceinline__ float shx(float v, int mask, int lane) { return __int_as_float(__builtin_amdgcn_ds_bpermute((lane ^ mask) << 2, __float_as_int(v))); }
__device__ __forceinline__ float wave_sum(float v, int lane) {
#pragma unroll
    for (int o = 1; o < 64; o <<= 1) v += shx(v, o, lane);
    return v;
}
__device__ __forceinline__ float wave_max(float v, int lane) {
#pragma unroll
    for (int o = 1; o < 64; o <<= 1) v = fmaxf(v, shx(v, o, lane));
    return v;
}
__device__ __forceinline__ float fsigmoid(float x) { return __builtin_amdgcn_rcpf(1.0f + __expf(-x)); }
__device__ __forceinline__ float gelu_tanh(float y) {
    const float t = 0.7978845608028654f * (y + 0.044715f * y * y * y);
    return y * fsigmoid(2.0f * t);
}

#define XB_TMO      128
#define XB_XCNT(j)  (256  + 64 * (j))
#define XB_XSUB(j)  (1280 + 64 * (j))
#define XB_XGEN(j)  (2304 + 64 * (j))
#define XB_TOP      3328
#define XB_TOPGEN   3392
#define XCD_BAR_WORDS 3456
#define XB_SPIN_CAP (1u << 18)

__device__ __forceinline__ unsigned xb_ld(unsigned* p)              { return __hip_atomic_load(p, __ATOMIC_RELAXED, __HIP_MEMORY_SCOPE_AGENT); }
__device__ __forceinline__ unsigned xb_add(unsigned* p, unsigned v) { return __hip_atomic_fetch_add(p, v, __ATOMIC_RELAXED, __HIP_MEMORY_SCOPE_AGENT); }
__device__ __forceinline__ unsigned xb_xcc_id() { return (unsigned)__builtin_amdgcn_s_getreg((3 << 11) | 20) & 0xFu; }
#define XB_SPIN(cond, bar) do { unsigned _sp = 0; while (cond) { __builtin_amdgcn_s_sleep(1); \
    if ((++_sp & 255u) == 0u) { if (xb_ld(&(bar)[XB_TMO])) break; if (_sp > XB_SPIN_CAP) { atomicAdd(&(bar)[XB_TMO], 1u); break; } } } } while (0)

struct XcdBarrier {
    unsigned* bar; unsigned x;
    volatile LAS unsigned* st;
};

__device__ __forceinline__ XcdBarrier xcd_barrier_post(unsigned* bar, volatile LAS unsigned* st) {
    XcdBarrier b; b.bar = bar; b.x = xb_xcc_id(); b.st = st;
    if (threadIdx.x == 0) (void)xb_add(&bar[XB_XCNT(b.x)], 1u);
    return b;
}
__device__ __forceinline__ void xcd_barrier_complete(unsigned* bar, unsigned x, unsigned& nloc, unsigned& nx) {
    const unsigned G = gridDim.x * gridDim.y * gridDim.z;
    unsigned sum, cnt, mine, sp = 0u;
    for (;;) {
        sum = 0u; cnt = 0u; mine = 0u;
#pragma unroll
        for (unsigned j = 0; j < 16; ++j) { const unsigned c = xb_ld(&bar[XB_XCNT(j)]); sum += c; cnt += (c > 0u) ? 1u : 0u; mine = (j == x) ? c : mine; }
        if (sum == G) break;
        __builtin_amdgcn_s_sleep(1);
        if ((++sp & 255u) == 0u) { if (xb_ld(&bar[XB_TMO])) break; if (sp > XB_SPIN_CAP) { atomicAdd(&bar[XB_TMO], 1u); break; } }
    }
    nloc = mine > 0u ? mine : 1u; nx = cnt > 0u ? cnt : 1u;
}

__device__ __forceinline__ void xcd_barrier(const XcdBarrier& b, int wv) {
    asm volatile("s_waitcnt vmcnt(0)" ::: "memory");
    __syncthreads();
    if (opaque_tid(wv) == 0) {
        unsigned* bar = b.bar; unsigned bx = xb_xcc_id(); asm volatile("" : "+s"(bx));
        __builtin_amdgcn_s_waitcnt(0);
        unsigned nloc = b.st[0], nx = b.st[1];
        if (nloc == 0u) { xcd_barrier_complete(bar, bx, nloc, nx); b.st[0] = nloc; b.st[1] = nx; }
        const unsigned old = xb_add(&bar[XB_XSUB(bx)], 1u);
        const unsigned gen = old / nloc;
        if (old + 1u == (gen + 1u) * nloc) {
            __builtin_amdgcn_fence(__ATOMIC_RELEASE, "agent");
            asm volatile("s_waitcnt vmcnt(0)" ::: "memory");
            const unsigned og = xb_add(&bar[XB_TOP], 1u);
            const unsigned tg = og / nx;
            if (og + 1u == (tg + 1u) * nx) xb_add(&bar[XB_TOPGEN], 1u);
            else XB_SPIN(xb_ld(&bar[XB_TOPGEN]) == tg, bar);
            __builtin_amdgcn_fence(__ATOMIC_ACQUIRE, "agent");
            xb_add(&bar[XB_XGEN(bx)], 1u);
            asm volatile("s_waitcnt vmcnt(0)" ::: "memory");
        } else {
            XB_SPIN(xb_ld(&bar[XB_XGEN(bx)]) == gen, bar);
            __builtin_amdgcn_fence(__ATOMIC_ACQUIRE, "agent");
            asm volatile("s_waitcnt vmcnt(0)" ::: "memory");
        }
    }
    __syncthreads();
}


constexpr int BM = 256, BK = 64, HALF = 128, HTB = HALF * BK * 2, STAGE_BYTES = 8 * HTB;
constexpr int LDS_X = STAGE_BYTES;
constexpr int LDS_ST = STAGE_BYTES + 8192;
constexpr int LDS_STASH = STAGE_BYTES + 8192 + 64;
constexpr int LDS_BYTES = STAGE_BYTES + 8192 + 64 + 4096;
__device__ __forceinline__ int lds_byte(int r, int c) { const int st = (r >> 4) * 2 + (c >> 5), rr = r & 15, cc = c & 31, ob = rr * 64 + cc * 2; return st * 1024 + (ob ^ (((ob >> 9) & 1) << 5)); }
__device__ __forceinline__ void stage_rc(int b, int& R, int& C) { const int st = b / 1024, sb = b % 1024, swz = sb ^ (((sb >> 9) & 1) << 5); R = (st >> 1) * 16 + swz / 64; C = (st & 1) * 32 + (swz % 64) / 2; }
__device__ __forceinline__ int perm32(int rho) { const int n = rho >> 4, i = rho & 15; return 8 * (i >> 2) + 4 * n + (i & 3); }

struct Unit { const char* a; const char* b; long c; int i0, i1, i2, i3; };
struct GD {
    const bf16_t* A; const bf16_t* B; int lda, ldb, nt, n, d0, d1, d2; int sa[4], sb[4], sc[4];
    __device__ __forceinline__ bool unit(long L, Unit& u) const {
        if (L >= n) return false;
        int l = (int)L; const int i0 = l % d0; l /= d0; const int i1 = l % d1; l /= d1; const int i2 = l % d2; const int i3 = l / d2;
        u.i0 = i0; u.i1 = i1; u.i2 = i2; u.i3 = i3;
        u.a = (const char*)(A + (long)(i0 * sa[0] + i1 * sa[1] + i2 * sa[2] + i3 * sa[3]));
        u.b = (const char*)(B + (long)(i0 * sb[0] + i1 * sb[1] + i2 * sb[2] + i3 * sb[3]));
        u.c = (long)(i0 * sc[0] + i1 * sc[1] + i2 * sc[2] + i3 * sc[3]);
        return true;
    }
};
__device__ __forceinline__ GD gd_zero() { GD g; g.A = nullptr; g.B = nullptr; g.lda = g.ldb = 0; g.nt = 0; g.n = 0; g.d0 = g.d1 = g.d2 = 1;
    for (int i = 0; i < 4; ++i) { g.sa[i] = 0; g.sb[i] = 0; g.sc[i] = 0; } return g; }
__device__ __forceinline__ GD gd_plain(const bf16_t* A, int lda, const bf16_t* B, int ldb, int K, int nM, int nN, int ldc, int ctile) {
    GD g = gd_zero(); g.A = A; g.B = B; g.lda = lda; g.ldb = ldb; g.nt = K / BK; g.n = nM * nN; g.d0 = nM; g.d1 = nN; g.d2 = 1;
    g.sa[0] = 256 * lda; g.sb[1] = 256 * ldb; g.sc[0] = 256 * ldc; g.sc[1] = ctile; return g; }

typedef f32x4 Acc[2][2][4][2];

struct EpiF32 {
    static constexpr bool PERM = false, AFTER = false;
    float* C; int ldc; const float* bias; const float* scale;
    __device__ __forceinline__ void operator()(const Acc& acc, const Unit& u, int wr, int wc, int fr, int fq) const {
        const int cb = (int)(u.c % ldc);
        const int row0 = wr * 64 + fr, col0 = wc * 32 + 4 * fq;
        f32x4 bv[2][2], sv[2][2];
#pragma unroll
        for (int bj = 0; bj < 2; ++bj)
#pragma unroll
            for (int n = 0; n < 2; ++n) {
                bv[bj][n] = bias ? *(const f32x4*)(bias + cb + col0 + bj * HALF + n * 16) : (f32x4){0.f, 0.f, 0.f, 0.f};
                sv[bj][n] = scale ? *(const f32x4*)(scale + cb + col0 + bj * HALF + n * 16) : (f32x4){1.f, 1.f, 1.f, 1.f}; }
#pragma unroll
        for (int ai = 0; ai < 2; ++ai)
#pragma unroll
            for (int m = 0; m < 4; ++m) { float* rowp = C + u.c + (long)(row0 + ai * HALF + m * 16) * ldc + col0;
#pragma unroll
                for (int bj = 0; bj < 2; ++bj)
#pragma unroll
                    for (int n = 0; n < 2; ++n) *(f32x4*)(rowp + bj * HALF + n * 16) = (acc[ai][bj][m][n] + bv[bj][n]) * sv[bj][n]; }
    }
};
struct EpiF32Bf16 {
    static constexpr bool PERM = false, AFTER = false;
    float* C; bf16_t* O; int ldc;
    __device__ __forceinline__ void operator()(const Acc& acc, const Unit& u, int wr, int wc, int fr, int fq) const {
        const int row0 = wr * 64 + fr, col0 = wc * 32 + 4 * fq;
#pragma unroll
        for (int ai = 0; ai < 2; ++ai)
#pragma unroll
            for (int m = 0; m < 4; ++m) { const long off = u.c + (long)(row0 + ai * HALF + m * 16) * ldc + col0;
#pragma unroll
                for (int bj = 0; bj < 2; ++bj)
#pragma unroll
                    for (int n = 0; n < 2; ++n) { const f32x4 v = acc[ai][bj][m][n]; *(f32x4*)(C + off + bj * HALF + n * 16) = v;
                        u32x2 w; w.x = cvt_pk_bf16(v[0], v[1]); w.y = cvt_pk_bf16(v[2], v[3]); *(u32x2*)(O + off + bj * HALF + n * 16) = w; } }
    }
};
struct EpiBf16 {
    static constexpr bool PERM = true, AFTER = false;
    bf16_t* O; int ldc; float s;
    __device__ __forceinline__ void operator()(const Acc& acc, const Unit& u, int wr, int wc, int fr, int fq) const {
        const int row0 = wr * 64 + fr, col0 = wc * 32 + 8 * fq;
#pragma unroll
        for (int ai = 0; ai < 2; ++ai)
#pragma unroll
            for (int m = 0; m < 4; ++m) { bf16_t* rowp = O + u.c + (long)(row0 + ai * HALF + m * 16) * ldc + col0;
#pragma unroll
                for (int bj = 0; bj < 2; ++bj) { const f32x4 v0 = acc[ai][bj][m][0] * s, v1 = acc[ai][bj][m][1] * s;
                    u32x4 w; w.x = cvt_pk_bf16(v0[0], v0[1]); w.y = cvt_pk_bf16(v0[2], v0[3]); w.z = cvt_pk_bf16(v1[0], v1[1]); w.w = cvt_pk_bf16(v1[2], v1[3]);
                    *(u32x4*)(rowp + bj * HALF) = w; } }
    }
};
struct EpiSwiGLU {
    static constexpr bool PERM = true, AFTER = false;
    bf16_t* O; int ldc;
    __device__ __forceinline__ void operator()(const Acc& acc, const Unit& u, int wr, int wc, int fr, int fq) const {
        const int row0 = wr * 64 + fr, col0 = wc * 32 + 8 * fq;
#pragma unroll
        for (int ai = 0; ai < 2; ++ai)
#pragma unroll
            for (int m = 0; m < 4; ++m) { bf16_t* rowp = O + u.c + (long)(row0 + ai * HALF + m * 16) * ldc + col0;
                float r[8];
#pragma unroll
                for (int n = 0; n < 2; ++n)
#pragma unroll
                    for (int j = 0; j < 4; ++j) { const float g = acc[ai][0][m][n][j], up = acc[ai][1][m][n][j]; r[n * 4 + j] = g * fsigmoid(g) * up; }
                u32x4 w; w.x = cvt_pk_bf16(r[0], r[1]); w.y = cvt_pk_bf16(r[2], r[3]); w.z = cvt_pk_bf16(r[4], r[5]); w.w = cvt_pk_bf16(r[6], r[7]);
                *(u32x4*)rowp = w; }
    }
};
struct EpiGLU {
    static constexpr bool PERM = false, AFTER = false;
    float* C; int ldc;
    __device__ __forceinline__ void operator()(const Acc& acc, const Unit& u, int wr, int wc, int fr, int fq) const {
        const int row0 = wr * 64 + fr, col0 = wc * 32 + 4 * fq;
#pragma unroll
        for (int ai = 0; ai < 2; ++ai)
#pragma unroll
            for (int m = 0; m < 4; ++m) { float* rowp = C + u.c + (long)(row0 + ai * HALF + m * 16) * ldc + col0;
#pragma unroll
                for (int n = 0; n < 2; ++n) { f32x4 o;
#pragma unroll
                    for (int j = 0; j < 4; ++j) o[j] = acc[ai][0][m][n][j] * fsigmoid(acc[ai][1][m][n][j]);
                    *(f32x4*)(rowp + n * 16) = o; } }
    }
};
struct EpiS5U {
    static constexpr bool PERM = true, AFTER = false;
    bf16_t* Ub;
    __device__ __forceinline__ void operator()(const Acc& acc, const Unit& u, int wr, int wc, int fr, int fq) const {
#pragma unroll
        for (int ai = 0; ai < 2; ++ai)
#pragma unroll
            for (int m = 0; m < 4; ++m) { const int tok = u.i0 * 256 + ai * HALF + wr * 64 + m * 16 + fr;
#pragma unroll
                for (int bj = 0; bj < 2; ++bj) { const int g = u.i1 * 16 + 8 * bj + 2 * wc + (fq >> 1);
                    bf16_t* dst = Ub + (long)g * USTRIDE + (long)(tok >> 4) * UK + (tok & 15) * 16 + (fq & 1) * 8;
                    const f32x4 v0 = acc[ai][bj][m][0], v1 = acc[ai][bj][m][1];
                    u32x4 w; w.x = cvt_pk_bf16(v0[0], v0[1]); w.y = cvt_pk_bf16(v0[2], v0[3]); w.z = cvt_pk_bf16(v1[0], v1[1]); w.w = cvt_pk_bf16(v1[2], v1[3]);
                    *(u32x4*)dst = w; } }
    }
};
struct EpiS5S {
    static constexpr bool PERM = false, AFTER = false;
    float* Sb;
    __device__ __forceinline__ void operator()(const Acc& acc, const Unit& u, int wr, int wc, int fr, int fq) const {
#pragma unroll
        for (int ai = 0; ai < 2; ++ai)
#pragma unroll
            for (int m = 0; m < 4; ++m) { const int row = u.i0 * 256 + ai * HALF + wr * 64 + m * 16 + fr;
                if (row < CR) { float* rowp = Sb + ((long)u.i1 * CR + row) * 128 + wc * 32 + 4 * fq;
#pragma unroll
                    for (int n = 0; n < 2; ++n) *(f32x4*)(rowp + n * 16) = acc[ai][0][m][n]; } }
    }
};
struct EpiS5D {
    static constexpr bool PERM = true, AFTER = false;
    const bf16_t* Ub; const float* dvec; bf16_t* Zb;
    __device__ __forceinline__ void operator()(const Acc& acc, const Unit& u, int wr, int wc, int fr, int fq) const {
        const int g = u.i1, c0 = (fq & 1) * 8;
        const f32x4 d0 = *(const f32x4*)(dvec + g * 16 + c0), d1 = *(const f32x4*)(dvec + g * 16 + c0 + 4);
#pragma unroll
        for (int ai = 0; ai < 2; ++ai)
#pragma unroll
            for (int m = 0; m < 4; ++m) { const int row = u.i0 * 256 + ai * HALF + wr * 64 + m * 16 + fr;
                if (row < CR) {
#pragma unroll
                    for (int bj = 0; bj < 2; ++bj) { const int jt = 8 * bj + 2 * wc + (fq >> 1);
                        const u32x4 uu = *(const u32x4*)(Ub + (long)g * USTRIDE + (long)row * UK + jt * 16 + c0);
                        float y[8];
#pragma unroll
                        for (int q = 0; q < 4; ++q) { const unsigned w = uu[q]; const float ulo = __uint_as_float(w << 16), uhi = __uint_as_float(w & 0xffff0000u);
                            const float dl = (q < 2) ? d0[2 * q] : d1[2 * q - 4], dh = (q < 2) ? d0[2 * q + 1] : d1[2 * q - 3];
                            const float al = (q < 2) ? acc[ai][bj][m][0][2 * q] : acc[ai][bj][m][1][2 * q - 4], ah = (q < 2) ? acc[ai][bj][m][0][2 * q + 1] : acc[ai][bj][m][1][2 * q - 3];
                            y[2 * q] = gelu_tanh(al + dl * ulo); y[2 * q + 1] = gelu_tanh(ah + dh * uhi); }
                        u32x4 w; w.x = cvt_pk_bf16(y[0], y[1]); w.y = cvt_pk_bf16(y[2], y[3]); w.z = cvt_pk_bf16(y[4], y[5]); w.w = cvt_pk_bf16(y[6], y[7]);
                        *(u32x4*)(Zb + (long)(row * 16 + jt) * D + g * 16 + c0) = w; } } }
    }
};
struct EpiSoftmax {
    static constexpr bool PERM = true, AFTER = false;
    bf16_t* O; int ldc; LAS float* Xl;
    __device__ __forceinline__ void operator()(const Acc& acc, const Unit& u, int wr, int wc, int fr, int fq) const {
        float mx[2][4]; const int ln = fr + 16 * fq;
#pragma unroll
        for (int ai = 0; ai < 2; ++ai)
#pragma unroll
            for (int m = 0; m < 4; ++m) { float a = -3.0e38f;
#pragma unroll
                for (int bj = 0; bj < 2; ++bj)
#pragma unroll
                    for (int n = 0; n < 2; ++n)
#pragma unroll
                        for (int j = 0; j < 4; ++j) a = fmaxf(a, acc[ai][bj][m][n][j]);
                a = fmaxf(a, shx(a, 16, ln)); a = fmaxf(a, shx(a, 32, ln));
                float s = 0.f;
#pragma unroll
                for (int bj = 0; bj < 2; ++bj)
#pragma unroll
                    for (int n = 0; n < 2; ++n)
#pragma unroll
                        for (int j = 0; j < 4; ++j) s += __expf(acc[ai][bj][m][n][j] - a);
                s += shx(s, 16, ln); s += shx(s, 32, ln);
                mx[ai][m] = a;
                const int r = ai * HALF + wr * 64 + m * 16 + fr;
                if (fq == 0) { Xl[(r * 4 + wc) * 2] = a; Xl[(r * 4 + wc) * 2 + 1] = s; } }
        asm volatile("s_waitcnt lgkmcnt(0)" ::: "memory"); __builtin_amdgcn_s_barrier(); asm volatile("" ::: "memory");
#pragma unroll
        for (int ai = 0; ai < 2; ++ai)
#pragma unroll
            for (int m = 0; m < 4; ++m) { const int r = ai * HALF + wr * 64 + m * 16 + fr;
                const f32x4 p0 = *(const LAS f32x4*)(Xl + r * 8), p1 = *(const LAS f32x4*)(Xl + r * 8 + 4);
                const float M = fmaxf(fmaxf(p0[0], p0[2]), fmaxf(p1[0], p1[2]));
                const float Ls = p0[1] * __expf(p0[0] - M) + p0[3] * __expf(p0[2] - M) + p1[1] * __expf(p1[0] - M) + p1[3] * __expf(p1[2] - M);
                const float inv = __builtin_amdgcn_rcpf(Ls);
                bf16_t* rowp = O + u.c + (long)r * ldc + wc * 32 + 8 * fq;
#pragma unroll
                for (int bj = 0; bj < 2; ++bj) { float e[8];
#pragma unroll
                    for (int n = 0; n < 2; ++n)
#pragma unroll
                        for (int j = 0; j < 4; ++j) e[n * 4 + j] = __expf(acc[ai][bj][m][n][j] - M) * inv;
                    u32x4 w; w.x = cvt_pk_bf16(e[0], e[1]); w.y = cvt_pk_bf16(e[2], e[3]); w.z = cvt_pk_bf16(e[4], e[5]); w.w = cvt_pk_bf16(e[6], e[7]);
                    *(u32x4*)(rowp + bj * HALF) = w; } }
        (void)mx;
    }
};


__device__ __forceinline__ void xs_wait(unsigned* cnt, unsigned want) {
    const unsigned long long t0 = __builtin_amdgcn_s_memrealtime();
    while (__hip_atomic_load(cnt, __ATOMIC_RELAXED, __HIP_MEMORY_SCOPE_AGENT) < want) {
        if (__builtin_amdgcn_s_memrealtime() - t0 > 2000000ull) break;
        __builtin_amdgcn_s_sleep(1); }
    asm volatile("" ::: "memory");
}
typedef unsigned long long u64;
template <int NS>
__device__ __forceinline__ float xs_poll_sum(u64* sl, unsigned epoch) {
    float tot; unsigned sp = 0;
    for (;;) { u64 v[NS]; bool ok = true; tot = 0.f;
#pragma unroll
        for (int t = 0; t < NS; ++t) v[t] = __hip_atomic_load(sl + t, __ATOMIC_RELAXED, __HIP_MEMORY_SCOPE_AGENT);
#pragma unroll
        for (int t = 0; t < NS; ++t) { ok = ok && ((unsigned)(v[t] >> 32) == epoch); tot += __uint_as_float((unsigned)v[t]); }
        if (ok || ++sp > (1u << 18)) break;
        __builtin_amdgcn_s_sleep(1); }
    return tot;
}
__device__ __forceinline__ void panel_exchange(const float (&ss)[2][4], int pm, int pn, u64* xs, unsigned epoch, float mult, LAS float* L, int tid, int wr, int wc, int fr, int fq) {
    if (fq == 0) {
#pragma unroll
        for (int ai = 0; ai < 2; ++ai)
#pragma unroll
            for (int m = 0; m < 4; ++m) L[(ai * HALF + wr * 64 + m * 16 + fr) * 4 + wc] = ss[ai][m]; }
    lds_barrier();
    if (tid < 256) { const f32x4 q = *(const LAS f32x4*)(L + tid * 4); u64* sl = xs + ((long)pm * 256 + tid) * 4;
        __hip_atomic_store(sl + pn, ((u64)epoch << 32) | (u64)__float_as_uint((q[0] + q[1]) + (q[2] + q[3])), __ATOMIC_RELAXED, __HIP_MEMORY_SCOPE_AGENT);
        const float tot = xs_poll_sum<4>(sl, epoch);
        L[1024 + tid] = mult * rsqrtf(tot * (1.0f / D) + EPS); }
    lds_barrier();
}
struct EpiRes {
    static constexpr bool PERM = false, AFTER = true;
    float* Xp; const float* Xr; const float* gpost; float w; const float* gpre; bf16_t* Hp; const float* bias; const float* scale;
    u64* xs1; u64* xs2; unsigned ep1, ep2; LAS float* L;
    __device__ __forceinline__ void fused(Acc& acc, const Unit& u, int tid, int wr, int wc, int fr, int fq) const {
        const int row0g = (int)(u.c >> 10), cb = (int)(u.c & 1023), pm = row0g >> 8, pn = cb >> 8, ln = fr + 16 * fq;
        const int col0 = cb + wc * 32 + 4 * fq;
        float ss[2][4];
        if (bias) {
#pragma unroll
            for (int bj = 0; bj < 2; ++bj)
#pragma unroll
                for (int n = 0; n < 2; ++n) { const f32x4 bv = *(const f32x4*)(bias + col0 + bj * HALF + n * 16), sv = *(const f32x4*)(scale + col0 + bj * HALF + n * 16);
#pragma unroll
                    for (int ai = 0; ai < 2; ++ai)
#pragma unroll
                        for (int m = 0; m < 4; ++m) acc[ai][bj][m][n] = (acc[ai][bj][m][n] + bv) * sv; } }
#pragma unroll
        for (int ai = 0; ai < 2; ++ai)
#pragma unroll
            for (int m = 0; m < 4; ++m) { float a = 0.f;
#pragma unroll
                for (int bj = 0; bj < 2; ++bj)
#pragma unroll
                    for (int n = 0; n < 2; ++n) { const f32x4 v = acc[ai][bj][m][n]; a += (v[0] * v[0] + v[1] * v[1]) + (v[2] * v[2] + v[3] * v[3]); }
                a += shx(a, 16, ln); a += shx(a, 32, ln); ss[ai][m] = a; }
        f32x4 xv[4][2][2];
#pragma unroll
        for (int m = 0; m < 4; ++m) { const float* xrow = Xr + (long)(row0g + wr * 64 + m * 16 + fr) * D + col0;
#pragma unroll
            for (int bj = 0; bj < 2; ++bj)
#pragma unroll
                for (int n = 0; n < 2; ++n) xv[m][bj][n] = *(const f32x4*)(xrow + bj * HALF + n * 16); }
        panel_exchange(ss, pm, pn, xs1, ep1, w, L, tid, wr, wc, fr, fq);
#pragma unroll
        for (int ai = 0; ai < 2; ++ai) {
            f32x4 gp[2][2];
#pragma unroll
            for (int bj = 0; bj < 2; ++bj)
#pragma unroll
                for (int n = 0; n < 2; ++n) gp[bj][n] = *(const f32x4*)(gpost + col0 + bj * HALF + n * 16);
            if (ai == 1) {
#pragma unroll
                for (int m = 0; m < 4; ++m) { const float* xrow = Xr + (long)(row0g + HALF + wr * 64 + m * 16 + fr) * D + col0;
#pragma unroll
                    for (int bj = 0; bj < 2; ++bj)
#pragma unroll
                        for (int n = 0; n < 2; ++n) xv[m][bj][n] = *(const f32x4*)(xrow + bj * HALF + n * 16); }
            }
#pragma unroll
            for (int m = 0; m < 4; ++m) { const int r = ai * HALF + wr * 64 + m * 16 + fr; const float rs = L[1024 + r]; float a = 0.f;
                float* xrow = Xp + (long)(row0g + r) * D + col0;
#pragma unroll
                for (int bj = 0; bj < 2; ++bj)
#pragma unroll
                    for (int n = 0; n < 2; ++n) { const f32x4 v = xv[m][bj][n] + acc[ai][bj][m][n] * gp[bj][n] * rs; acc[ai][bj][m][n] = v; if (Hp == nullptr) *(f32x4*)(xrow + bj * HALF + n * 16) = v;
                        a += (v[0] * v[0] + v[1] * v[1]) + (v[2] * v[2] + v[3] * v[3]); }
                a += shx(a, 16, ln); a += shx(a, 32, ln); ss[ai][m] = a; }
        }
        if (Hp == nullptr) return;
        panel_exchange(ss, pm, pn, xs2, ep2, 1.0f, L, tid, wr, wc, fr, fq);
#pragma unroll
        for (int ai = 0; ai < 2; ++ai)
#pragma unroll
            for (int m = 0; m < 4; ++m) { const int r = ai * HALF + wr * 64 + m * 16 + fr; const float rs = L[1024 + r];
                const int off = (row0g + r) * D + col0; bf16_t* hrow = Hp + off; float* xrow = Xp + off;
#pragma unroll
                for (int bj = 0; bj < 2; ++bj)
#pragma unroll
                    for (int n = 0; n < 2; ++n) { const f32x4 gp = *(const f32x4*)(gpre + col0 + bj * HALF + n * 16); const f32x4 o = acc[ai][bj][m][n] * gp * rs;
                        *(f32x4*)(xrow + bj * HALF + n * 16) = acc[ai][bj][m][n];
                        u32x2 wv; wv.x = cvt_pk_bf16(o[0], o[1]); wv.y = cvt_pk_bf16(o[2], o[3]); *(u32x2*)(hrow + bj * HALF + n * 16) = wv; } }
    }
};

struct NoHook { __device__ __forceinline__ void operator()() const {} };
template <class Epi, class Hook>
__device__ __forceinline__ void gemm_run(LAS unsigned char* lds, const GD g, const Epi& E, int rot, int wv, const Hook& hook) {
    const int tid = opaque_tid(wv), wid = __builtin_amdgcn_readfirstlane(tid >> 6), lane = tid & 63, wr = wid >> 2, wc = wid & 3, fr = lane & 15, fq = lane >> 4;
    const int nt = g.nt, G = gridDim.x;
    int cblk = blockIdx.x; asm volatile("" : "+s"(cblk)); cblk += rot; if (cblk >= G) cblk -= G;
    unsigned voffA[2], voffB[2];
#pragma unroll
    for (int i = 0; i < 2; ++i) { int R, C; stage_rc(tid * 16 + i * 8192, R, C); const int Rb = Epi::PERM ? ((R & ~31) + perm32(R & 31)) : R;
        voffA[i] = (unsigned)(R * g.lda + C) * 2u; voffB[i] = (unsigned)(Rb * g.ldb + C) * 2u; }
    const size_t kstep = (size_t)(BK * 2);
    const size_t hstepA = (size_t)HALF * g.lda * 2, hstepB = (size_t)HALF * g.ldb * 2;
    const unsigned ldsw = (unsigned)wid * 1024u;
    const int aoff = lds_byte(wr * 64 + fr, fq * 8), boff = lds_byte(wc * 32 + fr, fq * 8);
#define PG8_SA(b, h) (((b) * 2 + (h)) * HTB)
#define PG8_SB(b, h) ((4 + (b) * 2 + (h)) * HTB)
#define PG8_STAGE(bufoff, gbase, voff) do { _Pragma("unroll") for (int _i = 0; _i < 2; ++_i) \
        __builtin_amdgcn_global_load_lds((const unsigned*)((const char*)(gbase) + (voff)[_i]), (LAS unsigned*)(lds + (bufoff) + ldsw + _i * 8192), 16, 0, 0); } while (0)
#define PG8_LDA(dst, b, h) do { _Pragma("unroll") for (int m = 0; m < 4; ++m) _Pragma("unroll") for (int k = 0; k < 2; ++k) dst[m][k] = *(const LAS bf16x8*)(lds + PG8_SA(b, h) + aoff + m * 2048 + k * 1024); } while (0)
#define PG8_LDB(dst, b, h) do { _Pragma("unroll") for (int n = 0; n < 2; ++n) _Pragma("unroll") for (int k = 0; k < 2; ++k) dst[n][k] = *(const LAS bf16x8*)(lds + PG8_SB(b, h) + boff + n * 2048 + k * 1024); } while (0)
#define PG8_MMA(ai, bj, At, Bt) do { __builtin_amdgcn_s_setprio(1); _Pragma("unroll") for (int m = 0; m < 4; ++m) _Pragma("unroll") for (int n = 0; n < 2; ++n) _Pragma("unroll") for (int k = 0; k < 2; ++k) \
        acc[ai][bj][m][n] = __builtin_amdgcn_mfma_f32_16x16x32_bf16(Bt[n][k], At[m][k], acc[ai][bj][m][n], 0, 0, 0); __builtin_amdgcn_s_setprio(0); } while (0)
#define PG8_WAIT_V(n) asm volatile("s_waitcnt vmcnt(" #n ")" ::: "memory")
#define PG8_WAIT_L(n) asm volatile("s_waitcnt lgkmcnt(" #n ")" ::: "memory")
#define PG8_BAR __builtin_amdgcn_s_barrier()
#define PG8_SCHED __builtin_amdgcn_sched_barrier(0)
    Unit cur, nxt; int ui = 0;
    if (!g.unit(cblk, cur)) return;
    Acc acc;
#pragma unroll
    for (int a = 0; a < 2; ++a)
#pragma unroll
        for (int b = 0; b < 2; ++b)
#pragma unroll
            for (int m = 0; m < 4; ++m)
#pragma unroll
                for (int n = 0; n < 2; ++n) acc[a][b][m][n] = (f32x4){0.f, 0.f, 0.f, 0.f};
    bf16x8 At[4][2], B0[2][2], B1[2][2];
    const char* cA = cur.a; const char* cB = cur.b;
    PG8_STAGE(PG8_SB(0, 0), cB, voffB); PG8_STAGE(PG8_SB(0, 1), cB + hstepB, voffB); PG8_STAGE(PG8_SA(0, 0), cA, voffA); PG8_STAGE(PG8_SA(0, 1), cA + hstepA, voffA);
    if (wr == 1) PG8_BAR;
    PG8_WAIT_V(2); PG8_BAR;
    PG8_STAGE(PG8_SB(1, 0), cB + kstep, voffB); PG8_STAGE(PG8_SA(1, 0), cA + kstep, voffA); PG8_STAGE(PG8_SB(1, 1), cB + hstepB + kstep, voffB);
    PG8_WAIT_V(6); PG8_BAR;
    for (;;) {
        const bool has_next = g.unit((long)(ui + 1) * G + cblk, nxt);
        const char* nA = has_next ? nxt.a : cA; const char* nB = has_next ? nxt.b : cB;
        for (int t = 0; t < nt; t += 2) {
            const bool last = (t == nt - 2);
            const char* a1 = cA + (size_t)(t + 1) * kstep;
            const char* a2 = last ? nA : cA + (size_t)(t + 2) * kstep; const char* b2 = last ? nB : cB + (size_t)(t + 2) * kstep;
            const char* a3 = a2 + kstep; const char* b3 = b2 + kstep;
            PG8_LDB(B0, 0, 0); PG8_LDB(B1, 0, 1); PG8_SCHED; PG8_LDA(At, 0, 0); PG8_STAGE(PG8_SA(1, 1), a1 + hstepA, voffA);
            PG8_WAIT_V(8); PG8_WAIT_L(0); PG8_BAR; PG8_MMA(0, 0, At, B0); PG8_MMA(0, 1, At, B1); PG8_BAR; PG8_SCHED;
            PG8_LDA(At, 0, 1); PG8_STAGE(PG8_SB(0, 0), b2, voffB); PG8_STAGE(PG8_SB(0, 1), b2 + hstepB, voffB); PG8_STAGE(PG8_SA(0, 0), a2, voffA);
            PG8_WAIT_V(8); PG8_WAIT_L(0); PG8_BAR; PG8_MMA(1, 0, At, B0); PG8_MMA(1, 1, At, B1); PG8_BAR; PG8_SCHED;
            PG8_LDB(B0, 1, 0); PG8_LDB(B1, 1, 1); PG8_SCHED; PG8_LDA(At, 1, 0); PG8_STAGE(PG8_SA(0, 1), a2 + hstepA, voffA);
            PG8_WAIT_V(8); PG8_WAIT_L(0); PG8_BAR; PG8_MMA(0, 0, At, B0); PG8_MMA(0, 1, At, B1); PG8_BAR; PG8_SCHED;
            PG8_LDA(At, 1, 1); PG8_STAGE(PG8_SB(1, 0), b3, voffB); PG8_STAGE(PG8_SB(1, 1), b3 + hstepB, voffB); PG8_STAGE(PG8_SA(1, 0), a3, voffA);
            PG8_WAIT_V(8); PG8_WAIT_L(0); PG8_BAR; PG8_MMA(1, 0, At, B0); PG8_MMA(1, 1, At, B1); PG8_BAR; PG8_SCHED;
        }
        if (wr == 0) PG8_BAR;
        if constexpr (!Epi::AFTER) E(acc, cur, wr, wc, fr, fq);
        if (!has_next) break;
#pragma unroll
        for (int a = 0; a < 2; ++a)
#pragma unroll
            for (int b = 0; b < 2; ++b)
#pragma unroll
                for (int m = 0; m < 4; ++m)
#pragma unroll
                    for (int n = 0; n < 2; ++n) acc[a][b][m][n] = (f32x4){0.f, 0.f, 0.f, 0.f};
        cur = nxt; cA = nA; cB = nB; ++ui;
        if (wr == 1) PG8_BAR;
    }
    PG8_WAIT_V(0);
    PG8_BAR;
    if constexpr (Epi::AFTER) { hook(); E.fused(acc, cur, tid, wr, wc, fr, fq); }
#undef PG8_SA
#undef PG8_SB
#undef PG8_STAGE
#undef PG8_LDA
#undef PG8_LDB
#undef PG8_MMA
#undef PG8_WAIT_V
#undef PG8_WAIT_L
#undef PG8_BAR
#undef PG8_SCHED
}
template <class Epi>
__device__ __forceinline__ void gemm_run(LAS unsigned char* lds, const GD g, const Epi& E, int rot, int wv) { gemm_run(lds, g, E, rot, wv, NoHook{}); }


struct SkF32 { float* C; int ldc; const float* bias; const float* scale;
    __device__ __forceinline__ void operator()(int row, int col, const float (&v)[2][2]) const {
#pragma unroll
        for (int q = 0; q < 2; ++q) { const float b = bias ? bias[col + q] : 0.f, sc = scale ? scale[col + q] : 1.f; C[(long)row * ldc + col + q] = (v[0][q] + b) * sc; } } };
struct SkBf16 { bf16_t* O; int ldc;
    __device__ __forceinline__ void operator()(int row, int col, const float (&v)[2][2]) const { *(unsigned*)(O + (long)row * ldc + col) = cvt_pk_bf16(v[0][0], v[0][1]); } };
struct SkSwiGLU { bf16_t* O; int ldc;
    __device__ __forceinline__ void operator()(int row, int col, const float (&v)[2][2]) const {
        *(unsigned*)(O + (long)row * ldc + col) = cvt_pk_bf16(v[0][0] * fsigmoid(v[0][0]) * v[1][0], v[0][1] * fsigmoid(v[0][1]) * v[1][1]); } };
struct SkGLU { float* C; int ldc;
    __device__ __forceinline__ void operator()(int row, int col, const float (&v)[2][2]) const {
        C[(long)row * ldc + col] = v[0][0] * fsigmoid(v[1][0]); C[(long)row * ldc + col + 1] = v[0][1] * fsigmoid(v[1][1]); } };
struct SkS5U { bf16_t* Ub;
    __device__ __forceinline__ void operator()(int row, int col, const float (&v)[2][2]) const { const int tok = TP + row, g = col >> 4;
        *(unsigned*)(Ub + (long)g * USTRIDE + (long)(tok >> 4) * UK + (tok & 15) * 16 + (col & 15)) = cvt_pk_bf16(v[0][0], v[0][1]); } };

template <int NT, class Epi>
__device__ __forceinline__ void skinny(unsigned char* shm, const bf16_t* A, int lda, const bf16_t* B, int ldb, int K, int ncg, bool pair, int agd, const Epi& E, int cu0, int ncu, int wv) {
    float* red = (float*)shm;
    const int tid = opaque_tid(wv), wid = tid >> 6, lane = tid & 63, fr = lane & 15, fq = lane >> 4;
    int cblk = blockIdx.x; asm volatile("" : "+s"(cblk));
    cblk -= cu0; if (cblk < 0 || cblk >= ncu) return;
    const int kslice = K >> 3, steps = kslice >> 5, nitems = 4 * ncg;
    for (int item = cblk; item < nitems; item += ncu) {
        const int rb = item & 3, cgi = item >> 2;
        const int brow = pair ? ((cgi >> 3) * 256 + (cgi & 7) * 16) : cgi * 16;
        const bf16_t* ap = A + (long)(rb * 64 + fr) * lda + (cgi / agd) * 256 + wid * kslice + fq * 8;
        const bf16_t* bp = B + (long)(brow + fr) * ldb + wid * kslice + fq * 8;
        f32x4 acc[NT][4];
#pragma unroll
        for (int t = 0; t < NT; ++t)
#pragma unroll
            for (int m = 0; m < 4; ++m) acc[t][m] = (f32x4){0.f, 0.f, 0.f, 0.f};
#pragma unroll 4
        for (int st = 0; st < steps; ++st) {
            bf16x8 af[4], bfr[NT];
#pragma unroll
            for (int m = 0; m < 4; ++m) af[m] = *(const bf16x8*)(ap + (long)m * 16 * lda + st * 32);
#pragma unroll
            for (int t = 0; t < NT; ++t) bfr[t] = *(const bf16x8*)(bp + (long)t * 128 * ldb + st * 32);
#pragma unroll
            for (int t = 0; t < NT; ++t)
#pragma unroll
                for (int m = 0; m < 4; ++m) acc[t][m] = __builtin_amdgcn_mfma_f32_16x16x32_bf16(af[m], bfr[t], acc[t][m], 0, 0, 0);
        }
        lds_barrier();
#pragma unroll
        for (int t = 0; t < NT; ++t)
#pragma unroll
            for (int m = 0; m < 4; ++m)
#pragma unroll
                for (int jj = 0; jj < 4; ++jj) red[((wid * NT + t) * 4 + m) * 256 + (4 * fq + jj) * 16 + fr] = acc[t][m][jj];
        lds_barrier();
        { const int e = tid * 2, row = e >> 4, col = e & 15; float v[2][2];
#pragma unroll
          for (int t = 0; t < 2; ++t) { v[t][0] = 0.f; v[t][1] = 0.f;
              if (t < NT) {
#pragma unroll
                  for (int w = 0; w < 8; ++w) { const float* rp = red + ((w * NT + t) * 4 + (row >> 4)) * 256 + (row & 15) * 16 + col; v[t][0] += rp[0]; v[t][1] += rp[1]; } } }
          E(rb * 64 + row, cgi * 16 + col, v); }
    }
    __syncthreads();
}

struct SR { const bf16_t* A; int lda; const bf16_t* B; int ldb, K, agd; const float* bias; const float* scale; float* Xs; const float* Xsr; const float* gpost; float w; const float* gpre; bf16_t* Hs;
            u64* xs1; u64* xs2; unsigned ep1, ep2; };
__device__ __forceinline__ void sk_publish(float ssq, u64* xs, unsigned epoch, int rb, int cgi, int row, int tid, int lane) {
    ssq += shx(ssq, 1, lane); ssq += shx(ssq, 2, lane); ssq += shx(ssq, 4, lane);
    if ((tid & 7) == 0) __hip_atomic_store(xs + (long)(rb * 64 + row) * 64 + cgi, ((u64)epoch << 32) | (u64)__float_as_uint(ssq), __ATOMIC_RELAXED, __HIP_MEMORY_SCOPE_AGENT);
}
__device__ __forceinline__ float sk_collect(u64* xs, unsigned epoch, int rb, int row, float mult, int tid, int lane) {
    float tot = xs_poll_sum<8>(xs + (long)(rb * 64 + row) * 64 + (tid & 7) * 8, epoch);
    tot += shx(tot, 1, lane); tot += shx(tot, 2, lane); tot += shx(tot, 4, lane);
    return mult * rsqrtf(tot * (1.0f / D) + EPS);
}
__device__ __forceinline__ float sk_exchange(float ssq, int rb, int cgi, int row, u64* xs, unsigned epoch, float mult, int tid, int lane) {
    sk_publish(ssq, xs, epoch, rb, cgi, row, tid, lane);
    return sk_collect(xs, epoch, rb, row, mult, tid, lane);
}
template <int MODE>
__device__ __forceinline__ void skinny_res(unsigned char* shm, const SR& a, int wv) {
    float* red = (float*)shm;
    const int tid = opaque_tid(wv), wid = tid >> 6, lane = tid & 63, fr = lane & 15, fq = lane >> 4;
    int item = blockIdx.x; asm volatile("" : "+s"(item));
    if (item >= 256) return;
    const int kslice = a.K >> 3, steps = kslice >> 5;
    const int rb = item & 3, cgi = item >> 2;
    const int e = tid * 2, row = e >> 4, col = e & 15, gcol = cgi * 16 + col, grow = rb * 64 + row;
    float* stash = (float*)(shm + LDS_STASH);
    float* xp = a.Xs + (long)grow * D + gcol;
    float v0 = 0.f, v1 = 0.f, x0, x1;
    if constexpr (MODE <= 1) {
        const bf16_t* ap = a.A + (long)(rb * 64 + fr) * a.lda + (cgi / a.agd) * 256 + wid * kslice + fq * 8;
        const bf16_t* bp = a.B + (long)(cgi * 16 + fr) * a.ldb + wid * kslice + fq * 8;
        f32x4 acc[4];
#pragma unroll
        for (int m = 0; m < 4; ++m) acc[m] = (f32x4){0.f, 0.f, 0.f, 0.f};
#pragma unroll 4
        for (int st = 0; st < steps; ++st) {
            bf16x8 af[4], bfr;
#pragma unroll
            for (int m = 0; m < 4; ++m) af[m] = *(const bf16x8*)(ap + (long)m * 16 * a.lda + st * 32);
            bfr = *(const bf16x8*)(bp + st * 32);
#pragma unroll
            for (int m = 0; m < 4; ++m) acc[m] = __builtin_amdgcn_mfma_f32_16x16x32_bf16(af[m], bfr, acc[m], 0, 0, 0);
        }
        lds_barrier();
#pragma unroll
        for (int m = 0; m < 4; ++m)
#pragma unroll
            for (int jj = 0; jj < 4; ++jj) red[(wid * 4 + m) * 256 + (4 * fq + jj) * 16 + fr] = acc[m][jj];
        lds_barrier();
#pragma unroll
        for (int w8 = 0; w8 < 8; ++w8) { const float* rp = red + (w8 * 4 + (row >> 4)) * 256 + (row & 15) * 16 + col; v0 += rp[0]; v1 += rp[1]; }
        if (a.bias) { v0 = (v0 + a.bias[gcol]) * a.scale[gcol]; v1 = (v1 + a.bias[gcol + 1]) * a.scale[gcol + 1]; }
    }
    if constexpr (MODE == 1) {
        stash[tid * 2] = v0; stash[tid * 2 + 1] = v1;
        sk_publish(v0 * v0 + v1 * v1, a.xs1, a.ep1, rb, cgi, row, tid, lane);
        lds_barrier();
        return;
    }
    if constexpr (MODE == 0 || MODE == 2) {
        float rs1;
        if constexpr (MODE == 2) {
            v0 = stash[tid * 2]; v1 = stash[tid * 2 + 1];
            rs1 = sk_collect(a.xs1, a.ep1, rb, row, a.w, tid, lane);
        } else rs1 = sk_exchange(v0 * v0 + v1 * v1, rb, cgi, row, a.xs1, a.ep1, a.w, tid, lane);
        const float* xr = a.Xsr + (long)grow * D + gcol;
        x0 = xr[0] + v0 * a.gpost[gcol] * rs1; x1 = xr[1] + v1 * a.gpost[gcol + 1] * rs1;
        if (a.Hs == nullptr) { xp[0] = x0; xp[1] = x1; return; }
        if constexpr (MODE == 2) {
            stash[tid * 2] = x0; stash[tid * 2 + 1] = x1;
            sk_publish(x0 * x0 + x1 * x1, a.xs2, a.ep2, rb, cgi, row, tid, lane);
            return;
        }
    }
    float rs2;
    if constexpr (MODE == 3) {
        if (a.Hs == nullptr) return;
        x0 = stash[tid * 2]; x1 = stash[tid * 2 + 1];
        rs2 = sk_collect(a.xs2, a.ep2, rb, row, 1.0f, tid, lane);
    } else rs2 = sk_exchange(x0 * x0 + x1 * x1, rb, cgi, row, a.xs2, a.ep2, 1.0f, tid, lane);
    xp[0] = x0; xp[1] = x1;
    *(unsigned*)(a.Hs + (long)grow * D + gcol) = cvt_pk_bf16(x0 * a.gpre[gcol] * rs2, x1 * a.gpre[gcol + 1] * rs2);
    __syncthreads();
}
struct SkHook { unsigned char* shm; SR a; int wv; __device__ __forceinline__ void operator()() const { skinny_res<2>(shm, a, wv); } };

__device__ __forceinline__ void rows_phase(const float* xsrc, const float* f, const float* gpost, float w, const float* gpre, float* xdst, bf16_t* h, int r0, int r1, int wv) {
    const int tid = opaque_tid(wv); const int lane = tid & 63, gw = blockIdx.x * 8 + (tid >> 6), nw = gridDim.x * 8;
    for (int rbase = r0 + gw; rbase < r1; rbase += 2 * nw) {
        f32x4 xv[2][4], fv[2][4];
        const bool two = (rbase + nw) < r1;
#pragma unroll
        for (int q = 0; q < 2; ++q) { const int r = rbase + q * nw;
            if (q == 0 || two) {
#pragma unroll
                for (int k = 0; k < 4; ++k) { xv[q][k] = *(const f32x4*)(xsrc + (long)r * D + k * 256 + lane * 4); if (f) fv[q][k] = *(const f32x4*)(f + (long)r * D + k * 256 + lane * 4); } } }
#pragma unroll
        for (int q = 0; q < 2; ++q) { const int r = rbase + q * nw;
            if (q == 1 && !two) break;
            if (f) {
                float ss = 0.f;
#pragma unroll
                for (int k = 0; k < 4; ++k) ss += fv[q][k][0] * fv[q][k][0] + fv[q][k][1] * fv[q][k][1] + fv[q][k][2] * fv[q][k][2] + fv[q][k][3] * fv[q][k][3];
                ss = wave_sum(ss, lane);
                const float rs = w * rsqrtf(ss * (1.0f / D) + EPS);
#pragma unroll
                for (int k = 0; k < 4; ++k) { const f32x4 gp = *(const f32x4*)(gpost + k * 256 + lane * 4); xv[q][k] = xv[q][k] + fv[q][k] * gp * rs; }
            }
            if (xdst) {
#pragma unroll
                for (int k = 0; k < 4; ++k) *(f32x4*)(xdst + (long)r * D + k * 256 + lane * 4) = xv[q][k];
            }
            if (h) {
                float ss = 0.f;
#pragma unroll
                for (int k = 0; k < 4; ++k) ss += xv[q][k][0] * xv[q][k][0] + xv[q][k][1] * xv[q][k][1] + xv[q][k][2] * xv[q][k][2] + xv[q][k][3] * xv[q][k][3];
                ss = wave_sum(ss, lane);
                const float rs = rsqrtf(ss * (1.0f / D) + EPS);
#pragma unroll
                for (int k = 0; k < 4; ++k) { const f32x4 gp = *(const f32x4*)(gpre + k * 256 + lane * 4); const f32x4 o = xv[q][k] * gp * rs;
                    u32x2 wv; wv.x = cvt_pk_bf16(o[0], o[1]); wv.y = cvt_pk_bf16(o[2], o[3]); *(u32x2*)(h + (long)r * D + k * 256 + lane * 4) = wv; }
            }
        }
    }
}

struct TInfo { const float* src; bf16_t* dst; int lds, ldd, R0, C0, mode; };
__device__ __forceinline__ TInfo tconv_decode(const Params& p, int T) {
    int j = 0;
#pragma unroll 1
    for (int q = 1; q < NJOBS; ++q) if (T >= p.jobs[q].tile0) j = q;
    const TJob jb = p.jobs[j];
    int t = T - jb.tile0; const int per = jb.tr * jb.tc; const int b = t / per; t -= b * per; const int tr = t / jb.tc, tc = t % jb.tc;
    TInfo ti; ti.src = jb.src + (long)b * jb.sbs; ti.dst = jb.dst + (long)b * jb.dbs; ti.lds = jb.lds; ti.ldd = jb.ldd; ti.R0 = tr * 64; ti.C0 = tc * 64; ti.mode = jb.mode;
    return ti;
}
__device__ __forceinline__ void tconv_tiles(const Params& p, unsigned char* shm, int Tbase, int count, int cu0, int ncu, int wv) {
    bf16_t* tile = (bf16_t*)shm;
    const int tid = opaque_tid(wv);
    const int r = tid >> 3, c8 = (tid & 7) * 8;
    int cblk = blockIdx.x; asm volatile("" : "+s"(cblk));
    cblk -= cu0; if (cblk < 0 || cblk >= ncu || cblk >= count) return;
    const int Tend = Tbase + count;
    int T = Tbase + cblk;
    TInfo cur = tconv_decode(p, T);
    f32x4 v0 = *(const f32x4*)(cur.src + (long)(cur.R0 + r) * cur.lds + cur.C0 + c8), v1 = *(const f32x4*)(cur.src + (long)(cur.R0 + r) * cur.lds + cur.C0 + c8 + 4);
    for (;;) {
        const int Tn = T + ncu; const bool more = Tn < Tend;
        TInfo nxt = cur; f32x4 n0 = v0, n1 = v1;
        if (more) { nxt = tconv_decode(p, Tn);
            n0 = *(const f32x4*)(nxt.src + (long)(nxt.R0 + r) * nxt.lds + nxt.C0 + c8); n1 = *(const f32x4*)(nxt.src + (long)(nxt.R0 + r) * nxt.lds + nxt.C0 + c8 + 4); }
        const unsigned a0 = cvt_pk_bf16(v0[0], v0[1]), a1 = cvt_pk_bf16(v0[2], v0[3]), a2 = cvt_pk_bf16(v1[0], v1[1]), a3 = cvt_pk_bf16(v1[2], v1[3]);
        if (cur.mode == 3) { u32x4 w; w.x = a0; w.y = a1; w.z = a2; w.w = a3; *(u32x4*)(cur.dst + (long)(cur.R0 + r) * cur.ldd + cur.C0 + c8) = w; }
        else {
            tile[(c8 + 0) * 72 + r] = (bf16_t)(a0 & 0xffff); tile[(c8 + 1) * 72 + r] = (bf16_t)(a0 >> 16);
            tile[(c8 + 2) * 72 + r] = (bf16_t)(a1 & 0xffff); tile[(c8 + 3) * 72 + r] = (bf16_t)(a1 >> 16);
            tile[(c8 + 4) * 72 + r] = (bf16_t)(a2 & 0xffff); tile[(c8 + 5) * 72 + r] = (bf16_t)(a2 >> 16);
            tile[(c8 + 6) * 72 + r] = (bf16_t)(a3 & 0xffff); tile[(c8 + 7) * 72 + r] = (bf16_t)(a3 >> 16);
            asm volatile("s_waitcnt lgkmcnt(0)" ::: "memory"); __builtin_amdgcn_s_barrier(); asm volatile("" ::: "memory");
            { const int c = tid >> 3, r8 = (tid & 7) * 8; const int cc = cur.C0 + c;
              int drow = cc; if (cur.mode == 1) drow = (cc >> 7) * 256 + (cc & 127); else if (cur.mode == 2) drow = (cc >> 7) * 256 + 128 + (cc & 127);
              const u32x4 w = *(const u32x4*)(tile + c * 72 + r8);
              *(u32x4*)(cur.dst + (long)drow * cur.ldd + cur.R0 + r8) = w; }
            asm volatile("s_waitcnt lgkmcnt(0)" ::: "memory"); __builtin_amdgcn_s_barrier(); asm volatile("" ::: "memory");
        }
        if (!more) break;
        cur = nxt; v0 = n0; v1 = n1; T = Tn;
    }
    __syncthreads();
}

__device__ __forceinline__ void lam_pow(const Params& p, int j, int g, int pp, int n, float& re, float& im) {
    const double dt = exp((double)p.in[26][j * 64 + g]);
    const long gp = ((long)j * 64 + g) * 64 + pp;
    const double lr = (double)p.in[19][gp] * dt * n, li = (double)p.in[20][gp] * dt * n;
    const double red = li - 6.283185307179586476925 * rint(li * 0.15915494309189533577);
    const float mg = (float)exp(lr); float sn, cs; sincosf((float)red, &sn, &cs); re = mg * cs; im = mg * sn;
}
__device__ __forceinline__ void s5prep_phase(const Params& p, unsigned char* shm, int wv) {
    float* lamr = (float*)shm;
    float* lami = lamr + 17 * 64;
    float* Bbr = lami + 17 * 64;
    float* Bbi = Bbr + 1024;
    float* Ccr = Bbi + 1024;
    float* Cci = Ccr + 1024;
    float* Kt = Cci + 1024;
    const int tid = opaque_tid(wv);
    bf16_t* TV = (bf16_t*)(p.ws + O_TV); bf16_t* W5 = (bf16_t*)(p.ws + O_W5);
    for (int job = blockIdx.x; job < 128; job += gridDim.x) {
        const int j = job >> 6, g = job & 63;
        __syncthreads();
        if (tid < 64) {
            const int pp = tid; const long gp = ((long)j * 64 + g) * 64 + pp;
            const float dt = expf(p.in[26][j * 64 + g]);
            const float are = p.in[19][gp], aim = p.in[20][gp];
            const float lr = are * dt, li = aim * dt;
            for (int t = 0; t <= 16; ++t) { const float mg = expf(lr * t); float sn, cs; sincosf(li * t, &sn, &cs); lamr[t * 64 + pp] = mg * cs; lami[t * 64 + pp] = mg * sn; }
            const float nr = lamr[64 + pp] - 1.0f, ni = lami[64 + pp]; const float den = are * are + aim * aim;
            const float cr = (nr * are + ni * aim) / den, ci = (ni * are - nr * aim) / den;
            for (int c = 0; c < 16; ++c) { const float br = p.in[21][gp * 16 + c], bi = p.in[22][gp * 16 + c];
                Bbr[pp * 16 + c] = cr * br - ci * bi; Bbi[pp * 16 + c] = cr * bi + ci * br; }
            float q0, q1, q2, q3; lam_pow(p, j, g, pp, 16, q0, q1); lam_pow(p, j, g, pp, 1024, q2, q3);
            *(f32x4*)((float*)(p.ws + O_LAM) + gp * 4) = (f32x4){q0, q1, q2, q3};
        }
        for (int e = tid; e < 1024; e += 512) { const long gi = ((long)j * 64 + g) * 1024 + e; Ccr[e] = p.in[23][gi]; Cci[e] = p.in[24][gi]; }
        __syncthreads();
        for (int o = tid; o < 4096; o += 512) { const int tau = o >> 8, c = (o >> 4) & 15, cp = o & 15; float s = 0.f;
            for (int pp = 0; pp < 64; ++pp) { const float clr = Ccr[c * 64 + pp] * lamr[tau * 64 + pp] - Cci[c * 64 + pp] * lami[tau * 64 + pp];
                const float cli = Ccr[c * 64 + pp] * lami[tau * 64 + pp] + Cci[c * 64 + pp] * lamr[tau * 64 + pp];
                s += clr * Bbr[pp * 16 + cp] - cli * Bbi[pp * 16 + cp]; }
            Kt[o] = s; }
        __syncthreads();
        bf16_t* tv = TV + ((long)j * 64 + g) * 256 * UK;
        for (int e = tid; e < 256 * (UK / 2); e += 512) { const int n = e / (UK / 2), k = (e % (UK / 2)) * 2; const int jj = n >> 4, c = n & 15; float v[2];
#pragma unroll
            for (int q = 0; q < 2; ++q) { const int kk = k + q;
                if (kk < 256) { const int i = kk >> 4, cp = kk & 15; v[q] = (i <= jj) ? Kt[(jj - i) * 256 + c * 16 + cp] : 0.f; }
                else if (kk < 320) { const int pp = kk - 256; v[q] = Ccr[c * 64 + pp] * lamr[(jj + 1) * 64 + pp] - Cci[c * 64 + pp] * lami[(jj + 1) * 64 + pp]; }
                else { const int pp = kk - 320; v[q] = -(Ccr[c * 64 + pp] * lami[(jj + 1) * 64 + pp] + Cci[c * 64 + pp] * lamr[(jj + 1) * 64 + pp]); } }
            *(unsigned*)(tv + (long)n * UK + k) = cvt_pk_bf16(v[0], v[1]); }
        bf16_t* w5 = W5 + ((long)j * 64 + g) * 128 * 256;
        for (int e = tid; e < 128 * 128; e += 512) { const int n = e >> 7, k = (e & 127) * 2; const int pp = n & 63; const bool im = n >= 64; float v[2];
#pragma unroll
            for (int q = 0; q < 2; ++q) { const int kk = k + q, i = kk >> 4, cp = kk & 15; const int t = 15 - i;
                const float re = lamr[t * 64 + pp] * Bbr[pp * 16 + cp] - lami[t * 64 + pp] * Bbi[pp * 16 + cp];
                const float ii = lamr[t * 64 + pp] * Bbi[pp * 16 + cp] + lami[t * 64 + pp] * Bbr[pp * 16 + cp];
                v[q] = im ? ii : re; }
            *(unsigned*)(w5 + (long)n * 256 + k) = cvt_pk_bf16(v[0], v[1]); }
    }
    __syncthreads();
}

__device__ __forceinline__ void scan_phase(const Params& p, int j, unsigned char* shm, int wv) {
    float* E = (float*)shm;
    const int tid = opaque_tid(wv);
    const float* S = (const float*)(p.ws + O_S); bf16_t* U = (bf16_t*)(p.ws + O_U);
    for (int item = blockIdx.x; item < 128; item += gridDim.x) {
        const int seq = item >> 6, g = item & 63, pp = tid & 63, sc = tid >> 6;
        const f32x4 lq = *(const f32x4*)((const float*)(p.ws + O_LAM) + (((long)j * 64 + g) * 64 + pp) * 4); const float ar = lq[0], ai = lq[1], br = lq[2], bi = lq[3];
        const int row0 = seq * 512 + sc * 64;
        const float* Sg = S + ((long)g * CR + row0) * 128 + pp;
        float er = 0.f, ei = 0.f;
#pragma unroll 8
        for (int k = 0; k < 64; ++k) { const float sr = Sg[k * 128], si = Sg[k * 128 + 64]; const float nr = ar * er - ai * ei + sr, ni = ar * ei + ai * er + si; er = nr; ei = ni; }
        __syncthreads();
        E[(sc * 64 + pp) * 2] = er; E[(sc * 64 + pp) * 2 + 1] = ei;
        __syncthreads();
        float hr = 0.f, hi = 0.f;
        for (int m = 0; m < sc; ++m) { const float xr = E[(m * 64 + pp) * 2], xi = E[(m * 64 + pp) * 2 + 1]; const float nr = br * hr - bi * hi + xr, ni = br * hi + bi * hr + xi; hr = nr; hi = ni; }
        bf16_t* Ug = U + (long)g * USTRIDE + (long)row0 * UK + 256 + pp;
        for (int k0 = 0; k0 < 64; k0 += 8) { float sr[8], si[8];
#pragma unroll
            for (int k = 0; k < 8; ++k) { sr[k] = Sg[(k0 + k) * 128]; si[k] = Sg[(k0 + k) * 128 + 64]; }
#pragma unroll
            for (int k = 0; k < 8; ++k) {
                Ug[(k0 + k) * UK] = (bf16_t)(cvt_pk_bf16(hr, 0.f) & 0xffff); Ug[(k0 + k) * UK + 64] = (bf16_t)(cvt_pk_bf16(hi, 0.f) & 0xffff);
                const float nr = ar * hr - ai * hi + sr[k], ni = ar * hi + ai * hr + si[k]; hr = nr; hi = ni; } }
        if (sc == 7) { const long o = (((long)j * 2 + seq) * 64 + g) * 64 + pp; p.out[OO_SRP + o] = hr; p.out[OO_SIP + o] = hi; }
    }
    { const int lane = tid & 63, gw = blockIdx.x * 8 + (tid >> 6), nw = gridDim.x * 8;
      for (int item = gw; item < 512; item += nw) { const int s = item >> 6, g = item & 63, pp = lane;
          const f32x4 lq = *(const f32x4*)((const float*)(p.ws + O_LAM) + (((long)j * 64 + g) * 64 + pp) * 4); const float ar = lq[0], ai = lq[1];
          const long si = (((long)j * 8 + s) * 64 + g) * 64 + pp;
          float hr = p.in[4][si], hi = p.in[5][si];
          const int row0 = 1024 + 2 * s;
          const float* Sg = S + ((long)g * CR + row0) * 128 + pp;
          bf16_t* Ug = U + (long)g * USTRIDE + (long)row0 * UK + 256 + pp;
#pragma unroll
          for (int k = 0; k < 2; ++k) { const float sr = Sg[k * 128], sim = Sg[k * 128 + 64];
              Ug[k * UK] = (bf16_t)(cvt_pk_bf16(hr, 0.f) & 0xffff); Ug[k * UK + 64] = (bf16_t)(cvt_pk_bf16(hi, 0.f) & 0xffff);
              const float nr = ar * hr - ai * hi + sr, ni = ar * hi + ai * hr + sim; hr = nr; hi = ni; }
          p.out[OO_SRS + si] = hr; p.out[OO_SIS + si] = hi; } }
}

__device__ __forceinline__ f32x4 pool_row(const float* F, const float* hist, int base, int t, int col) {
    if (t >= 0) return *(const f32x4*)(F + (long)(base + t) * D + col);
    if (hist) return *(const f32x4*)(hist + (long)(15 + t) * D + col);
    return (f32x4){0.f, 0.f, 0.f, 0.f};
}
__device__ __forceinline__ void pool_phase(const Params& p, int j, int wv) {
    const float* F = (const float*)(p.ws + O_F); bf16_t* Z = (bf16_t*)(p.ws + O_Z);
    const int tid = opaque_tid(wv); const int lane = tid & 63, gw = blockIdx.x * 8 + (tid >> 6), nw = gridDim.x * 8;
    for (int item = gw; item < 520 * 4; item += nw) {
        const int seg = item >> 2, grp = item & 3; const int W = 2 << grp; const int col = grp * 256 + lane * 4;
        const int tok0 = seg * 32;
        int base, t0, pos0; const float* hist = nullptr;
        if (tok0 < TP) { base = (tok0 >> 13) << 13; t0 = tok0 - base; pos0 = 0; }
        else { const int s = (tok0 - TP) >> 5; base = tok0; t0 = 0; pos0 = 1024; hist = p.in[6] + ((long)j * 8 + s) * 15 * D; }
        f32x4 sum = (f32x4){0.f, 0.f, 0.f, 0.f};
        { f32x4 pre[15];
#pragma unroll
          for (int k = 1; k < 16; ++k) pre[k - 1] = (k < W) ? pool_row(F, hist, base, t0 - k, col) : (f32x4){0.f, 0.f, 0.f, 0.f};
#pragma unroll
          for (int k = 0; k < 15; ++k) sum = sum + pre[k]; }
        for (int i0 = 0; i0 < 32; i0 += 8) {
            f32x4 un[8], ut[8];
#pragma unroll
            for (int i = 0; i < 8; ++i) { const int t = t0 + i0 + i; un[i] = *(const f32x4*)(F + (long)(base + t) * D + col); ut[i] = pool_row(F, hist, base, t - W + 1, col); }
#pragma unroll
            for (int i = 0; i < 8; ++i) { const int t = t0 + i0 + i; sum = sum + un[i];
                const int cnt = min(pos0 + t + 1, W); const float inv = 1.0f / (float)cnt;
                const f32x4 o = sum * inv - un[i];
                u32x2 wv; wv.x = cvt_pk_bf16(o[0], o[1]); wv.y = cvt_pk_bf16(o[2], o[3]); *(u32x2*)(Z + (long)(base + t) * D + col) = wv;
                sum = sum - ut[i]; }
        }
    }
    for (int e = blockIdx.x * 512 + tid; e < 10 * 15 * 256; e += gridDim.x * 512) {
        const int c4 = (e & 255) * 4, r = (e >> 8) % 15, sq = (e >> 8) / 15;
        if (sq < 2) { const f32x4 v = *(const f32x4*)(F + (long)(sq * 8192 + 8177 + r) * D + c4); *(f32x4*)(p.out + OO_PP + (((long)j * 2 + sq) * 15 + r) * D + c4) = v; }
        else { const int s = sq - 2; const f32x4 v = *(const f32x4*)(F + (long)(TP + s * 32 + 17 + r) * D + c4); *(f32x4*)(p.out + OO_PS + (((long)j * 8 + s) * 15 + r) * D + c4) = v; }
    }
}

__device__ __forceinline__ void sample_attn_phase(const Params& p, int l, unsigned char* shm, int wv) {
    float* Ssm = (float*)shm;
    float* Vs = Ssm + 32 * 256;
    const int tid = opaque_tid(wv), wid = tid >> 6, lane = tid & 63, fr = lane & 15, fq = lane >> 4;
    const bf16_t* Q = (const bf16_t*)(p.ws + O_Z) + (long)TP * D; bf16_t* Oo = (bf16_t*)(p.ws + O_H) + (long)TP * D;
    for (int item = blockIdx.x; item < 128; item += gridDim.x) {
        const int b = item >> 4, h = (item >> 2) & 3, dq = item & 3;
        const float* Kc = p.in[2] + (((long)l * 8 + b) * 256) * D + h * 256;
        const float* Vc = p.in[3] + (((long)l * 8 + b) * 256) * D + h * 256 + dq * 64;
        f32x4 vreg[8];
#pragma unroll
        for (int i = 0; i < 8; ++i) { const int idx = tid + 512 * i; vreg[i] = *(const f32x4*)(Vc + (long)(idx >> 4) * D + (idx & 15) * 4); }
        f32x4 acc[2][2];
#pragma unroll
        for (int a = 0; a < 2; ++a)
#pragma unroll
            for (int n = 0; n < 2; ++n) acc[a][n] = (f32x4){0.f, 0.f, 0.f, 0.f};
#pragma unroll 2
        for (int st = 0; st < 8; ++st) {
            bf16x8 af[2], bfr[2];
#pragma unroll
            for (int a = 0; a < 2; ++a) af[a] = *(const bf16x8*)(Q + (long)(b * 32 + a * 16 + fr) * D + h * 256 + st * 32 + fq * 8);
#pragma unroll
            for (int n = 0; n < 2; ++n) { const float* kp = Kc + (long)(wid * 32 + n * 16 + fr) * D + st * 32 + fq * 8;
                const f32x4 k0 = *(const f32x4*)kp, k1 = *(const f32x4*)(kp + 4);
                u32x4 w; w.x = cvt_pk_bf16(k0[0], k0[1]); w.y = cvt_pk_bf16(k0[2], k0[3]); w.z = cvt_pk_bf16(k1[0], k1[1]); w.w = cvt_pk_bf16(k1[2], k1[3]);
                bfr[n] = __builtin_bit_cast(bf16x8, w); }
#pragma unroll
            for (int a = 0; a < 2; ++a)
#pragma unroll
                for (int n = 0; n < 2; ++n) acc[a][n] = __builtin_amdgcn_mfma_f32_16x16x32_bf16(af[a], bfr[n], acc[a][n], 0, 0, 0);
        }
        __syncthreads();
#pragma unroll
        for (int a = 0; a < 2; ++a)
#pragma unroll
            for (int n = 0; n < 2; ++n)
#pragma unroll
                for (int jj = 0; jj < 4; ++jj) Ssm[(a * 16 + 4 * fq + jj) * 256 + wid * 32 + n * 16 + fr] = acc[a][n][jj] * 0.0625f;
#pragma unroll
        for (int i = 0; i < 8; ++i) { const int idx = tid + 512 * i; *(f32x4*)(Vs + (idx >> 4) * 64 + (idx & 15) * 4) = vreg[i]; }
        __syncthreads();
        for (int rr = 0; rr < 4; ++rr) { const int r = wid * 4 + rr; f32x4 v = *(const f32x4*)(Ssm + r * 256 + lane * 4);
            const float mxv = wave_max(fmaxf(fmaxf(v[0], v[1]), fmaxf(v[2], v[3])), lane);
            v[0] = __expf(v[0] - mxv); v[1] = __expf(v[1] - mxv); v[2] = __expf(v[2] - mxv); v[3] = __expf(v[3] - mxv);
            const float inv = 1.0f / wave_sum(v[0] + v[1] + v[2] + v[3], lane);
            *(f32x4*)(Ssm + r * 256 + lane * 4) = v * inv; }
        __syncthreads();
        { const int d = lane, qg = wid; float o[4] = {0.f, 0.f, 0.f, 0.f};
#pragma unroll 4
          for (int m4 = 0; m4 < 64; ++m4) { float vv[4];
#pragma unroll
              for (int k = 0; k < 4; ++k) vv[k] = Vs[(m4 * 4 + k) * 64 + d];
#pragma unroll
              for (int q = 0; q < 4; ++q) { const f32x4 pv = *(const f32x4*)(Ssm + (qg * 4 + q) * 256 + m4 * 4); o[q] += pv[0] * vv[0] + pv[1] * vv[1] + pv[2] * vv[2] + pv[3] * vv[3]; } }
#pragma unroll
          for (int q = 0; q < 4; ++q) Oo[(long)(b * 32 + qg * 4 + q) * D + h * 256 + dq * 64 + d] = (bf16_t)(cvt_pk_bf16(o[q], 0.f) & 0xffff); }
        __syncthreads();
    }
}

__global__ void __launch_bounds__(512, 2) mega(const Params p) {
    extern __shared__ __attribute__((aligned(16))) unsigned char shm[];
    cg::grid_group grid = cg::this_grid();
    LAS unsigned char* lds = (LAS unsigned char*)shm;
#define ws (opq_ptr(p.ws))
#define X ((float*)opq_ptr((unsigned char*)p.out))
#define H ((bf16_t*)(ws + O_H))
#define Z ((bf16_t*)(ws + O_Z))
#define F ((float*)(ws + O_F))
#define ACT ((bf16_t*)(ws + O_ACT))
#define U ((bf16_t*)(ws + O_U))
#define S ((float*)(ws + O_S))
#define npre ((const float*)opq_ptr((unsigned char*)p.in[8]))
#define npost ((const float*)opq_ptr((unsigned char*)p.in[9]))
#define CNT(id) ((unsigned*)(ws + O_CNT) + (id) * 4096)
#define XSP1 ((u64*)(ws + O_XS))
#define XSP2 ((u64*)(ws + O_XS) + 65536)
#define XSS1 ((u64*)(ws + O_XS) + 131072)
#define XSS2 ((u64*)(ws + O_XS) + 131072 + 16384)

    volatile LAS unsigned* xst = (volatile LAS unsigned*)(lds + LDS_ST);
    if (threadIdx.x == 0) { xst[0] = 0u; xst[1] = 0u; }
    __syncthreads();
    const int wv = __builtin_amdgcn_readfirstlane((int)(threadIdx.x >> 6));
    const XcdBarrier xb = xcd_barrier_post((unsigned*)(ws + O_BAR), xst);
    tconv_tiles(p, shm, 3 * 5632, p.ntiles - 3 * 5632, 0, (int)gridDim.x, wv);
#pragma unroll 1
    for (int jj = 0; jj < 2; ++jj) tconv_tiles(p, shm, jj * 5632, 2 * 704, 128, 128, wv);
    tconv_tiles(p, shm, 2 * 5632, 2 * 704, 0, (int)gridDim.x, wv);
    s5prep_phase(p, shm, wv);
#pragma unroll 1
    for (int l = 0; l < 4; ++l) rows_phase(p.in[7], nullptr, nullptr, 0.f, p.in[10] + l * D, nullptr, (bf16_t*)(ws + O_AMEM) + (long)l * 512 * D, 0, 512, wv);
    rows_phase(p.in[0], nullptr, nullptr, 0.f, npre, nullptr, H, 0, TP, wv);
    rows_phase(p.in[1] - (long)TP * D, nullptr, nullptr, 0.f, npre, nullptr, H, TP, TT, wv);
    grid.sync();

#pragma unroll 1
    for (int l = 0; l < 4; ++l) {
        const int j = l >> 1;
#pragma unroll 1
        for (int sub = 0; sub < 4; ++sub) {
            if (sub == 0 || sub == 3) {
                const int s = sub ? 1 : 0;
                { GD g = gd_plain(H, D, (const bf16_t*)(ws + O_WGU) + (long)(l * 2 + s) * 5632 * D, D, D, 65, 22, DFF, 128);
                  EpiSwiGLU e; e.O = ACT; e.ldc = DFF; gemm_run(lds, g, e, 0, wv); }
                if (l * 2 + s >= 1 && l * 2 + s < 7) {
#pragma unroll 1
                    for (int jj = 0; jj < 2; ++jj) tconv_tiles(p, shm, jj * 5632 + (l * 2 + s + 1) * 704, 704, 150, 106, wv);
                }
                if (l == 0 && sub == 0) {
    { GD g = gd_zero(); g.A = (const bf16_t*)(ws + O_AMEM); g.B = (const bf16_t*)(ws + O_WKT); g.lda = D; g.ldb = D; g.nt = 16; g.n = 64; g.d0 = 2; g.d1 = 4; g.d2 = 4;
      g.sa[0] = (int)(256L * D); g.sa[2] = (int)(512L * D); g.sb[1] = (int)(256L * D); g.sb[2] = (int)(M1); g.sb[3] = (int)(4 * M1);
      g.sc[0] = (int)(256L * D); g.sc[1] = (int)(256); g.sc[2] = (int)(512L * D); g.sc[3] = (int)(2097152L);
      EpiF32Bf16 e; e.C = p.out + OO_MEMK; e.O = (bf16_t*)(ws + O_KBF); e.ldc = D;
      gemm_run(lds, g, e, 106, wv); }
                }
                xcd_barrier(xb, wv);
                { const bool lastsub = (l == 3 && sub == 3); const int eid = l * 4 + sub;
                  const float* gpre_n = lastsub ? nullptr : npre + (sub == 0 ? (l * 4 + 1) : ((l + 1) * 4)) * D;
                  SR sr; sr.A = ACT + (long)TP * DFF; sr.lda = DFF; sr.B = (const bf16_t*)(ws + O_WDN) + (long)(l * 2 + s) * D * DFF; sr.ldb = DFF; sr.K = DFF; sr.agd = 1 << 20; sr.bias = nullptr; sr.scale = nullptr; sr.Xs = X + (long)TP * D; sr.Xsr = (l == 0 && sub == 0) ? (const float*)opq_ptr((unsigned char*)p.in[1]) : (const float*)(X + (long)TP * D); sr.gpost = npost + (l * 4 + sub) * D; sr.w = 0.5f; sr.gpre = gpre_n; sr.Hs = lastsub ? nullptr : H + (long)TP * D; sr.xs1 = XSS1; sr.xs2 = XSS2; sr.ep1 = (unsigned)(eid * 2 + 1); sr.ep2 = (unsigned)(eid * 2 + 2);
                  skinny_res<1>(shm, sr, wv);
                  GD g = gd_plain(ACT, DFF, (const bf16_t*)(ws + O_WDN) + (long)(l * 2 + s) * D * DFF, DFF, DFF, 64, 4, D, 256);
                  EpiRes e; e.Xp = X; e.Xr = (l == 0 && sub == 0) ? (const float*)opq_ptr((unsigned char*)p.in[0]) : (const float*)X; e.gpost = npost + (l * 4 + sub) * D; e.w = 0.5f; e.gpre = gpre_n; e.Hp = lastsub ? nullptr : H; e.bias = nullptr; e.scale = nullptr;
                  e.xs1 = XSP1; e.xs2 = XSP2; e.ep1 = (unsigned)(eid * 2 + 1); e.ep2 = (unsigned)(eid * 2 + 2); e.L = (LAS float*)(lds + LDS_X);
                  gemm_run(lds, g, e, 0, wv, SkHook{shm, sr, wv});
                  skinny_res<3>(shm, sr, wv);
                }
                xcd_barrier(xb, wv);
            } else if (sub == 1) {
                if ((l & 1) == 0) {
                    { GD g = gd_plain(H, D, (const bf16_t*)(ws + O_WSI) + (long)j * M1, D, D, 64, 4, D, 256);
                      EpiS5U e; e.Ub = U; gemm_run(lds, g, e, 0, wv); }
                    { SkS5U e; e.Ub = U;
                      skinny<1>(shm, H + (long)TP * D, D, (const bf16_t*)(ws + O_WSI) + (long)j * M1, D, D, 64, false, 1 << 20, e, 0, 256, wv); }
                    xcd_barrier(xb, wv);
                    { GD g = gd_zero(); g.A = U; g.B = (const bf16_t*)(ws + O_W5) + (long)j * 64 * 128 * 256; g.lda = UK; g.ldb = 256; g.nt = 4; g.n = 320; g.d0 = 5; g.d1 = 64; g.d2 = 1;
                      g.sa[0] = (int)(256L * UK); g.sa[1] = (int)(USTRIDE); g.sb[1] = (int)(128L * 256);
                      EpiS5S e; e.Sb = S; gemm_run(lds, g, e, 0, wv); }
                    tconv_tiles(p, shm, 2 * 5632 + (l == 0 ? 2 : 5) * 704, 704, 64, 192, wv);
                    xcd_barrier(xb, wv);
                    scan_phase(p, j, shm, wv);
                    if (l == 2) tconv_tiles(p, shm, 2 * 5632 + 6 * 704, 704, 128, 128, wv);
                    if (l == 0) {
    { GD g = gd_zero(); g.A = (const bf16_t*)(ws + O_KBF); g.B = (const bf16_t*)(ws + O_WQP); g.lda = D; g.ldb = D; g.nt = 4; g.n = 128; g.d0 = 4; g.d1 = 4; g.d2 = 2;
      g.sa[1] = (int)(256); g.sa[2] = (int)(256L * D); g.sa[3] = (int)(512L * D); g.sb[0] = (int)(256L * D); g.sb[1] = (int)(256); g.sb[3] = (int)(M1);
      g.sc[0] = (int)(256); g.sc[1] = (int)(256L * D); g.sc[2] = (int)(M1); g.sc[3] = (int)(2 * M1);
      EpiBf16 e; e.O = (bf16_t*)(ws + O_QK); e.ldc = D; e.s = 0.0625f;
      gemm_run(lds, g, e, 128, wv); }
    { GD g = gd_zero(); g.A = (const bf16_t*)(ws + O_WOT); g.B = (const bf16_t*)(ws + O_KBF) + 2097152L; g.lda = D; g.ldb = D; g.nt = 4; g.n = 128; g.d0 = 4; g.d1 = 4; g.d2 = 2;
      g.sa[0] = (int)(256L * D); g.sa[1] = (int)(256); g.sa[3] = (int)(M1); g.sb[1] = (int)(256); g.sb[2] = (int)(256L * D); g.sb[3] = (int)(512L * D);
      g.sc[0] = (int)(256L * D); g.sc[1] = (int)(256); g.sc[2] = (int)(M1); g.sc[3] = (int)(2 * M1);
      EpiBf16 e; e.O = (bf16_t*)(ws + O_VW); e.ldc = D; e.s = 1.0f;
      gemm_run(lds, g, e, 128, wv); }
                    }
                    xcd_barrier(xb, wv);
                    { GD g = gd_zero(); g.A = U; g.B = (const bf16_t*)(ws + O_TV) + (long)j * 64 * 256 * UK; g.lda = UK; g.ldb = UK; g.nt = 6; g.n = 320; g.d0 = 5; g.d1 = 64; g.d2 = 1;
                      g.sa[0] = (int)(256L * UK); g.sa[1] = (int)(USTRIDE); g.sb[1] = (int)(256L * UK);
                      EpiS5D e; e.Ub = U; e.dvec = p.in[25] + j * D; e.Zb = Z; gemm_run(lds, g, e, 0, wv); }
                    tconv_tiles(p, shm, 2 * 5632 + (l == 0 ? 3 : 7) * 704, 704, 64, 192, wv);
                    xcd_barrier(xb, wv);
                    { GD g = gd_plain(Z, D, (const bf16_t*)(ws + O_WGL) + (long)j * 2048 * D, D, D, 64, 8, D, 128);
                      EpiGLU e; e.C = F; e.ldc = D; gemm_run(lds, g, e, 0, wv); }
                    { SkGLU e; e.C = F + (long)TP * D; e.ldc = D;
                      skinny<2>(shm, Z + (long)TP * D, D, (const bf16_t*)(ws + O_WGL) + (long)j * 2048 * D, D, D, 64, true, 1 << 20, e, 0, 256, wv); }
                    xcd_barrier(xb, wv);
                    rows_phase(X, F, npost + (l * 4 + 1) * D, 1.0f, npre + (l * 4 + 2) * D, X, H, 0, TT, wv);
                    xcd_barrier(xb, wv);
                } else {
                    { GD g = gd_plain(H, D, (const bf16_t*)(ws + O_WPI) + (long)j * M1, D, D, 64, 4, D, 256);
                      EpiF32 e; e.C = F; e.ldc = D; e.bias = nullptr; e.scale = nullptr; gemm_run(lds, g, e, 0, wv); }
                    { SkF32 e; e.C = F + (long)TP * D; e.ldc = D; e.bias = nullptr; e.scale = nullptr;
                      skinny<1>(shm, H + (long)TP * D, D, (const bf16_t*)(ws + O_WPI) + (long)j * M1, D, D, 64, false, 1 << 20, e, 0, 256, wv); }
                    xcd_barrier(xb, wv);
                    pool_phase(p, j, wv);
                    xcd_barrier(xb, wv);
                    { const int eid = l * 4 + 1;
                      SR sr; sr.A = Z + (long)TP * D; sr.lda = D; sr.B = (const bf16_t*)(ws + O_WGR) + (long)j * 4 * 65536; sr.ldb = 256; sr.K = 256; sr.agd = 16; sr.bias = p.in[30] + j * D; sr.scale = p.in[31] + j * D; sr.Xs = X + (long)TP * D; sr.Xsr = X + (long)TP * D; sr.gpost = npost + (l * 4 + 1) * D; sr.w = 1.0f; sr.gpre = npre + (l * 4 + 2) * D; sr.Hs = H + (long)TP * D; sr.xs1 = XSS1; sr.xs2 = XSS2; sr.ep1 = (unsigned)(eid * 2 + 1); sr.ep2 = (unsigned)(eid * 2 + 2);
                      skinny_res<1>(shm, sr, wv);
                      GD g = gd_zero(); g.A = Z; g.B = (const bf16_t*)(ws + O_WGR) + (long)j * 4 * 65536; g.lda = D; g.ldb = 256; g.nt = 4; g.n = 256; g.d0 = 64; g.d1 = 4; g.d2 = 1;
                      g.sa[0] = (int)(256L * D); g.sa[1] = (int)(256); g.sb[1] = (int)(65536); g.sc[0] = (int)(256L * D); g.sc[1] = (int)(256);
                      EpiRes e; e.Xp = X; e.Xr = X; e.gpost = npost + (l * 4 + 1) * D; e.w = 1.0f; e.gpre = npre + (l * 4 + 2) * D; e.Hp = H; e.bias = p.in[30] + j * D; e.scale = p.in[31] + j * D;
                      e.xs1 = XSP1; e.xs2 = XSP2; e.ep1 = (unsigned)(eid * 2 + 1); e.ep2 = (unsigned)(eid * 2 + 2); e.L = (LAS float*)(lds + LDS_X);
                      gemm_run(lds, g, e, 0, wv, SkHook{shm, sr, wv});
                      skinny_res<3>(shm, sr, wv); }
                    xcd_barrier(xb, wv);
                }
            } else {
                { GD g = gd_zero(); g.A = H; g.B = (const bf16_t*)(ws + O_QK) + (long)l * 2 * M1; g.lda = D; g.ldb = D; g.nt = 16; g.n = 256; g.d0 = 32; g.d1 = 2; g.d2 = 4;
                  g.sa[0] = (int)(256L * D); g.sa[1] = (int)(32L * 256 * D); g.sb[1] = (int)(M1); g.sb[2] = (int)(256L * D); g.sc[0] = (int)(256L * D); g.sc[1] = (int)(32L * 256 * D); g.sc[2] = (int)(256);
                  EpiSoftmax e; e.O = Z; e.ldc = D; e.Xl = (LAS float*)(lds + LDS_X); gemm_run(lds, g, e, 0, wv); }
                { SkBf16 e; e.O = Z + (long)TP * D; e.ldc = D;
                  skinny<1>(shm, H + (long)TP * D, D, (const bf16_t*)(ws + O_WQT) + (long)l * M1, D, D, 64, false, 1 << 20, e, 0, 256, wv); }
                xcd_barrier(xb, wv);
                { const int eid = l * 4 + 2;
                  GD g = gd_zero(); g.A = Z; g.B = (const bf16_t*)(ws + O_VW) + (long)l * 2 * M1; g.lda = D; g.ldb = D; g.nt = 16; g.n = 256; g.d0 = 32; g.d1 = 2; g.d2 = 4;
                  g.sa[0] = (int)(256L * D); g.sa[1] = (int)(32L * 256 * D); g.sb[1] = (int)(M1); g.sb[2] = (int)(256L * D); g.sc[0] = (int)(256L * D); g.sc[1] = (int)(32L * 256 * D); g.sc[2] = (int)(256);
                  EpiRes e; e.Xp = X; e.Xr = X; e.gpost = npost + (l * 4 + 2) * D; e.w = 1.0f; e.gpre = npre + (l * 4 + 3) * D; e.Hp = H; e.bias = nullptr; e.scale = nullptr;
                  e.xs1 = XSP1; e.xs2 = XSP2; e.ep1 = (unsigned)(eid * 2 + 1); e.ep2 = (unsigned)(eid * 2 + 2); e.L = (LAS float*)(lds + LDS_X);
                  gemm_run(lds, g, e, 0, wv); }
                sample_attn_phase(p, l, shm, wv);
                if (l == 1) tconv_tiles(p, shm, 2 * 5632 + 4 * 704, 704, 128, 128, wv);
                xcd_barrier(xb, wv);
                { const int eid = l * 4 + 2;
                  SR sr; sr.A = H + (long)TP * D; sr.lda = D; sr.B = (const bf16_t*)(ws + O_WOT) + (long)l * M1; sr.ldb = D; sr.K = D; sr.agd = 1 << 20; sr.bias = nullptr; sr.scale = nullptr; sr.Xs = X + (long)TP * D; sr.Xsr = X + (long)TP * D; sr.gpost = npost + (l * 4 + 2) * D; sr.w = 1.0f; sr.gpre = npre + (l * 4 + 3) * D; sr.Hs = H + (long)TP * D; sr.xs1 = XSS1; sr.xs2 = XSS2; sr.ep1 = (unsigned)(eid * 2 + 1); sr.ep2 = (unsigned)(eid * 2 + 2); skinny_res<0>(shm, sr, wv); }
                xcd_barrier(xb, wv);
            }
        }
    }
}
#undef ws
#undef X
#undef H
#undef Z
#undef F
#undef ACT
#undef U
#undef S
#undef npre
#undef npost
#undef CNT
#undef XSP1
#undef XSP2
#undef XSS1
#undef XSS2

static void add_job(Params& p, int& nj, int& tiles, const float* src, bf16_t* dst, int R, int C, int lds, int ldd, int mode, int nb, long sbs, long dbs) {
    TJob& j = p.jobs[nj++]; j.src = src; j.dst = dst; j.sbs = sbs; j.dbs = dbs; j.lds = lds; j.ldd = ldd; j.tr = R / 64; j.tc = C / 64; j.mode = mode; j.nb = nb; j.tile0 = tiles; j.pad = 0;
    tiles += nb * j.tr * j.tc;
}

extern "C" void kernel_launch(void* const* d_in, const int* in_sizes, int n_in, void* d_out, int out_size, void* d_ws, size_t ws_size, hipStream_t stream) {
    static int grid_blocks = 0;
    if (grid_blocks == 0) {
        if (n_in != 32 || (long)out_size != OUT_TOTAL || ws_size < WS_END) {
            fprintf(stderr, "kernel_launch: unexpected shapes (n_in %d out %d ws %zu need %zu)\n", n_in, out_size, ws_size, (size_t)WS_END); grid_blocks = -1; return; }
        int dev = 0, cus = 0, per_cu = 0;
        hipGetDevice(&dev);
        hipDeviceGetAttribute(&cus, hipDeviceAttributeMultiprocessorCount, dev);
        if (hipFuncSetAttribute((const void*)mega, hipFuncAttributeMaxDynamicSharedMemorySize, LDS_BYTES) != hipSuccess) { fprintf(stderr, "kernel_launch: hipFuncSetAttribute failed\n"); grid_blocks = -1; return; }
        if (hipOccupancyMaxActiveBlocksPerMultiprocessor(&per_cu, (const void*)mega, 512, LDS_BYTES) != hipSuccess || per_cu < 1) { fprintf(stderr, "kernel_launch: occupancy query failed (%d)\n", per_cu); (void)hipGetLastError(); per_cu = 1; }
        grid_blocks = cus * per_cu;
    }
    if (grid_blocks < 0) return;
    Params p; memset(&p, 0, sizeof(p));
    for (int i = 0; i < 32; ++i) p.in[i] = (const float*)d_in[i];
    p.out = (float*)d_out; p.ws = (unsigned char*)d_ws;
    unsigned char* ws = (unsigned char*)d_ws;
    int nj = 0, tiles = 0;
    const long WF = 1024L * 2816;
    add_job(p, nj, tiles, p.in[11], (bf16_t*)(ws + O_WGU), 1024, 2816, 2816, 1024, 1, 8, WF, 5632L * 1024);
    add_job(p, nj, tiles, p.in[12], (bf16_t*)(ws + O_WGU), 1024, 2816, 2816, 1024, 2, 8, WF, 5632L * 1024);
    add_job(p, nj, tiles, p.in[13], (bf16_t*)(ws + O_WDN), 2816, 1024, 1024, 2816, 0, 8, WF, WF);
    add_job(p, nj, tiles, p.in[14], (bf16_t*)(ws + O_WQT), 1024, 1024, 1024, 1024, 0, 4, M1, M1);
    add_job(p, nj, tiles, p.in[14], (bf16_t*)(ws + O_WQP), 1024, 1024, 1024, 1024, 3, 4, M1, M1);
    add_job(p, nj, tiles, p.in[15], (bf16_t*)(ws + O_WKT), 1024, 1024, 1024, 1024, 0, 4, M1, M1);
    add_job(p, nj, tiles, p.in[16], (bf16_t*)(ws + O_WKT) + 4 * M1, 1024, 1024, 1024, 1024, 0, 4, M1, M1);
    add_job(p, nj, tiles, p.in[17], (bf16_t*)(ws + O_WOT), 1024, 1024, 1024, 1024, 0, 4, M1, M1);
    add_job(p, nj, tiles, p.in[18], (bf16_t*)(ws + O_WSI), 1024, 1024, 1024, 1024, 0, 2, M1, M1);
    add_job(p, nj, tiles, p.in[27], (bf16_t*)(ws + O_WGL), 1024, 1024, 2048, 1024, 1, 2, 2 * M1, 2 * M1);
    add_job(p, nj, tiles, p.in[27] + 1024, (bf16_t*)(ws + O_WGL), 1024, 1024, 2048, 1024, 2, 2, 2 * M1, 2 * M1);
    add_job(p, nj, tiles, p.in[28], (bf16_t*)(ws + O_WPI), 1024, 1024, 1024, 1024, 0, 2, M1, M1);
    add_job(p, nj, tiles, p.in[29], (bf16_t*)(ws + O_WGR), 256, 256, 256, 256, 0, 8, 65536, 65536);
    while (nj < NJOBS) { TJob& j = p.jobs[nj++]; j.tile0 = 0x7fffffff; j.tr = 1; j.tc = 1; j.nb = 0; }
    p.ntiles = tiles;
    if (hipMemsetAsync((unsigned char*)d_ws + O_BAR, 0, O_H - O_BAR, stream) != hipSuccess) { fprintf(stderr, "kernel_launch: memset failed\n"); return; }
    void* args[] = {(void*)&p};
    hipError_t e = hipLaunchCooperativeKernel((const void*)mega, dim3(grid_blocks), dim3(512), args, LDS_BYTES, stream);
    if (e != hipSuccess) fprintf(stderr, "cooperative launch failed: %s (grid %d)\n", hipGetErrorString(e), grid_blocks);
}
```
